# Optimizing an MI355X kernel written in HIP

```python
import math
import jax, jax.numpy as jnp
from jax import lax
import numpy as np

D_MODEL = 1024
BATCH = 8
SEQ = 4096
DEPTH = 2

HEAD_DIM = 64
BRANCH_WIDTH = D_MODEL // 2
DIFF_HEADS = BRANCH_WIDTH // (2 * HEAD_DIM)
DIFF_VDIM = 2 * HEAD_DIM
FOX_HEADS = BRANCH_WIDTH // HEAD_DIM
DIL_HEADS = BRANCH_WIDTH // HEAD_DIM
DIL_PATTERNS = ((128, 1), (512, 4), (2048, 16))
N_BRANCHES = 3
Q_BLOCK = 128
RMS_EPS = 1e-6
ALIBI_MAX_EXP = 8.0

kernel_name = "hybrid_diff_fox_dilated_gated_block"

_SPLITS = (
    ("diff_q", 2 * DIFF_HEADS * HEAD_DIM), ("diff_k", 2 * DIFF_HEADS * HEAD_DIM),
    ("diff_v", DIFF_HEADS * DIFF_VDIM), ("diff_z", BRANCH_WIDTH),
    ("fox_q", FOX_HEADS * HEAD_DIM), ("fox_k", FOX_HEADS * HEAD_DIM),
    ("fox_v", FOX_HEADS * HEAD_DIM), ("fox_f", FOX_HEADS), ("fox_z", BRANCH_WIDTH),
    ("dil_q", DIL_HEADS * HEAD_DIM), ("dil_k", DIL_HEADS * HEAD_DIM),
    ("dil_v", DIL_HEADS * HEAD_DIM), ("dil_z", BRANCH_WIDTH),
    ("merge_g", N_BRANCHES * D_MODEL),
)
_NAMES = [n for n, _ in _SPLITS]
_OFFSETS = [int(o) for o in np.cumsum([w for _, w in _SPLITS])[:-1]]
IN_WIDTH = int(sum(w for _, w in _SPLITS))


def rmsnorm(x, g):
    xf = x.astype(jnp.float32)
    y = xf * lax.rsqrt(jnp.mean(xf * xf, axis=-1, keepdims=True) + RMS_EPS)
    return (y * g.astype(jnp.float32)).astype(x.dtype)


def alibi_slopes(n_heads):
    return jnp.asarray(np.power(2.0, -ALIBI_MAX_EXP * np.arange(1, n_heads + 1) / n_heads), dtype=jnp.float32)


def causal_sweep(block_fn, seq_len):
    return jnp.concatenate([block_fn(s, s + Q_BLOCK) for s in range(0, seq_len, Q_BLOCK)], axis=1)


def diff_attention(q, k, v, lam, slopes):
    seq_len = q.shape[1]
    scale = HEAD_DIM ** -0.5

    def block(start, end):
        s = jnp.einsum('bqhcd,bkhcd->bhcqk', q[:, start:end], k[:, :end]).astype(jnp.float32) * scale
        dist = (jnp.arange(start, end)[:, None] - jnp.arange(end)[None, :]).astype(jnp.float32)
        s = s - slopes[:, None, None, None] * dist
        s = jnp.where(dist >= 0, s, -jnp.inf)
        p = jax.nn.softmax(s, axis=-1)
        pd = p[:, :, 0] - lam * p[:, :, 1]
        return jnp.einsum('bhqk,bkhe->bqhe', pd, v[:, :end].astype(jnp.float32))

    return causal_sweep(block, seq_len)


def forgetting_attention(q, k, v, cum_logf):
    seq_len = q.shape[1]
    scale = HEAD_DIM ** -0.5
    c = cum_logf.transpose(0, 2, 1)

    def block(start, end):
        s = jnp.einsum('bqhd,bkhd->bhqk', q[:, start:end], k[:, :end]).astype(jnp.float32) * scale
        s = s + c[:, :, start:end, None] - c[:, :, None, :end]
        causal = jnp.arange(start, end)[:, None] >= jnp.arange(end)[None, :]
        s = jnp.where(causal, s, -jnp.inf)
        p = jax.nn.softmax(s, axis=-1)
        return jnp.einsum('bhqk,bkhd->bqhd', p, v[:, :end].astype(jnp.float32))

    return causal_sweep(block, seq_len)


def dilated_pattern(q, k, v, window, dilation, slopes):
    B, S, H, E = q.shape
    n = S // dilation
    L = window // dilation
    n_pad = -(-n // L) * L
    nb = n_pad // L
    scale = HEAD_DIM ** -0.5

    def to_sub(a):
        a = a.reshape(B, n, dilation, H, E).transpose(0, 2, 3, 1, 4)
        a = jnp.pad(a, ((0, 0), (0, 0), (0, 0), (0, n_pad - n), (0, 0)))
        return a.reshape(B, dilation, H, nb, L, E)

    def with_prev(a):
        prev = jnp.pad(a[:, :, :, :-1], ((0, 0), (0, 0), (0, 0), (1, 0), (0, 0), (0, 0)))
        return jnp.concatenate([prev, a], axis=4)

    qs = to_sub(q)
    kk = with_prev(to_sub(k))
    vv = with_prev(to_sub(v))
    s = jnp.einsum('brhnqe,brhnke->brhnqk', qs, kk).astype(jnp.float32) * scale
    i = jnp.arange(L)[:, None]
    j = jnp.arange(2 * L)[None, :]
    delta = L + i - j
    blk = jnp.arange(nb)[:, None, None]
    valid = (delta >= 0) & (delta <= L) & (blk * L + j - L >= 0)
    s = s - slopes[:, None, None, None] * (dilation * delta).astype(jnp.float32)
    s = jnp.where(valid, s, -jnp.inf)
    m = jnp.max(s, axis=-1, keepdims=True)
    e = jnp.exp(s - m)
    den = jnp.sum(e, axis=-1, keepdims=True)
    num = jnp.einsum('brhnqk,brhnke->brhnqe', e, vv.astype(jnp.float32))

    def from_sub(a):
        F = a.shape[-1]
        a = a.reshape(B, dilation, H, n_pad, F)[:, :, :, :n]
        return a.transpose(0, 3, 1, 2, 4).reshape(B, S, H, F)

    return from_sub(num), from_sub(m)[..., 0], from_sub(den)[..., 0]


def dilated_attention(q, k, v, slopes):
    res = [dilated_pattern(q, k, v, w, d, slopes) for w, d in DIL_PATTERNS]
    mx = jnp.max(jnp.stack([r[1] for r in res], axis=0), axis=0)
    num = sum(jnp.exp(r[1] - mx)[..., None] * r[0] for r in res)
    den = sum(jnp.exp(r[1] - mx) * r[2] for r in res)
    return num / den[..., None]


def setup_inputs(seed: int = 0) -> dict:
    key = jax.random.key(seed)
    ks = jax.random.split(key, 10)
    f32 = jnp.float32
    x = jax.random.normal(ks[0], (BATCH, SEQ, D_MODEL), f32)
    norm_g = 1.0 + 0.05 * jax.random.normal(ks[1], (DEPTH, D_MODEL), f32)
    w_in = jax.random.normal(ks[2], (DEPTH, D_MODEL, IN_WIDTH), f32) * D_MODEL ** -0.5
    fox_fb = jax.random.uniform(ks[3], (DEPTH, FOX_HEADS), f32, minval=1.0, maxval=4.0)
    diff_lam = 0.1 * jax.random.normal(ks[4], (DEPTH, 4, HEAD_DIM), f32)
    diff_norm_g = 1.0 + 0.05 * jax.random.normal(ks[5], (DEPTH, DIFF_HEADS * DIFF_VDIM), f32)
    w_branch = jax.random.normal(ks[6], (DEPTH, N_BRANCHES, BRANCH_WIDTH, D_MODEL), f32) * BRANCH_WIDTH ** -0.5
    w_out = jax.random.normal(ks[7], (DEPTH, D_MODEL, D_MODEL), f32) * D_MODEL ** -0.5
    final_g = 1.0 + 0.05 * jax.random.normal(ks[8], (D_MODEL,), f32)
    return {"x": x, "norm_g": norm_g, "w_in": w_in, "fox_fb": fox_fb, "diff_lam": diff_lam,
            "diff_norm_g": diff_norm_g, "w_branch": w_branch, "w_out": w_out, "final_g": final_g}


def reference(x, norm_g, w_in, fox_fb, diff_lam, diff_norm_g, w_branch, w_out, final_g):
    B, S, _ = x.shape
    diff_slopes = alibi_slopes(DIFF_HEADS)
    dil_slopes = alibi_slopes(DIL_HEADS)
    for l in range(DEPTH):
        h = rmsnorm(x, norm_g[l])
        proj = h @ w_in[l]
        p = dict(zip(_NAMES, jnp.split(proj, _OFFSETS, axis=-1)))

        lam_init = 0.8 - 0.6 * math.exp(-0.3 * l)
        dl = diff_lam[l].astype(jnp.float32)
        lam = jnp.exp(jnp.sum(dl[0] * dl[1])) - jnp.exp(jnp.sum(dl[2] * dl[3])) + lam_init
        qa = p["diff_q"].reshape(B, S, DIFF_HEADS, 2, HEAD_DIM)
        ka = p["diff_k"].reshape(B, S, DIFF_HEADS, 2, HEAD_DIM)
        va = p["diff_v"].reshape(B, S, DIFF_HEADS, DIFF_VDIM)
        oa = diff_attention(qa, ka, va, lam, diff_slopes)
        oa = rmsnorm(oa, diff_norm_g[l].reshape(DIFF_HEADS, DIFF_VDIM)) * (1.0 - lam_init)
        ya = oa.reshape(B, S, BRANCH_WIDTH).astype(x.dtype) * jax.nn.silu(p["diff_z"])

        logf = jax.nn.log_sigmoid(p["fox_f"].astype(jnp.float32) + fox_fb[l].astype(jnp.float32))
        cum_logf = jnp.cumsum(logf, axis=1)
        qb = p["fox_q"].reshape(B, S, FOX_HEADS, HEAD_DIM)
        kb = p["fox_k"].reshape(B, S, FOX_HEADS, HEAD_DIM)
        vb = p["fox_v"].reshape(B, S, FOX_HEADS, HEAD_DIM)
        ob = forgetting_attention(qb, kb, vb, cum_logf)
        yb = ob.reshape(B, S, BRANCH_WIDTH).astype(x.dtype) * jax.nn.silu(p["fox_z"])

        qc = p["dil_q"].reshape(B, S, DIL_HEADS, HEAD_DIM)
        kc = p["dil_k"].reshape(B, S, DIL_HEADS, HEAD_DIM)
        vc = p["dil_v"].reshape(B, S, DIL_HEADS, HEAD_DIM)
        oc = dilated_attention(qc, kc, vc, dil_slopes)
        yc = oc.reshape(B, S, BRANCH_WIDTH).astype(x.dtype) * jax.nn.silu(p["dil_z"])

        y = jnp.stack([ya, yb, yc], axis=2)
        gates = jax.nn.sigmoid(p["merge_g"]).reshape(B, S, N_BRANCHES, D_MODEL)
        branch = jnp.einsum('bsne,nef->bsnf', y, w_branch[l])
        merged = jnp.sum(gates * branch, axis=2)
        x = x + merged @ w_out[l]
    return rmsnorm(x, final_g)
```

```cpp
#include <hip/hip_runtime.h>
#include <cstdio>
#include <cstdint>

constexpr int NB = 8, SEQ = 4096, DM = 1024, MTOK = NB * SEQ, NLAYER = 2, INW = 9224, BW = 512;
constexpr float LOG2E = 1.4426950408889634f;
constexpr float QSCALE = 0.125f * LOG2E;
constexpr float RMS_EPS = 1e-6f;
constexpr size_t MiB = 1u << 20;
constexpr size_t WS_CTL = 0;
constexpr size_t WS_ALIBI = 512 * 1024;
constexpr size_t WS_W = 1 * MiB, W_LAYER = 23 * MiB;
constexpr size_t W_QKV = 0, W_ZG = 9 * MiB, W_B = 18 * MiB, W_O = 21 * MiB;
constexpr size_t WS_LOGF = 47 * MiB, WS_CL2 = 48 * MiB, WS_LSE = 49 * MiB;
constexpr size_t WS_XN = 52 * MiB;
constexpr size_t WS_QKV = 116 * MiB, QKV_BUF = 32 * MiB;
constexpr size_t WS_GATES = WS_QKV + 3 * QKV_BUF;
constexpr size_t WS_DILO = 404 * MiB;
constexpr size_t WS_END = 500 * MiB;
constexpr size_t CTL_ZERO_BYTES = 65536;
constexpr int CW_BAR = 4096;
constexpr int CW_QUEUE = 64;
constexpr int CW_LAM = 256;
namespace pg8 {
#define PG8_LAS __attribute__((address_space(3)))
typedef unsigned short bf16_t;
typedef short bf16x8 __attribute__((ext_vector_type(8)));
typedef float f32x4 __attribute__((ext_vector_type(4)));
typedef unsigned u32x4 __attribute__((ext_vector_type(4)));
constexpr int BM = 256, BK = 64, HALF = 128, HTB = HALF * BK * 2  , STAGE_BYTES = 8 * HTB, NXCD = 8, WGM = 8;

__host__ __device__ __forceinline__ int lds_byte(int r, int c) { const int st = (r >> 4) * 2 + (c >> 5), rr = r & 15, cc = c & 31, ob = rr * 64 + cc * 2; return st * 1024 + (ob ^ (((ob >> 9) & 1) << 5)); }
__host__ __device__ __forceinline__ void stage_rc(int b, int& R, int& C) { const int st = b / 1024, sb = b % 1024, swz = sb ^ (((sb >> 9) & 1) << 5); R = (st >> 1) * 16 + swz / 64; C = (st & 1) * 32 + (swz % 64) / 2; }
__host__ __device__ __forceinline__ int perm32(int rho) { const int n = rho >> 4, i = rho & 15; return 8 * (i >> 2) + 4 * n + (i & 3); }

struct Unit { int pm, pn; };
struct Gemm { const bf16_t* A; const bf16_t* Bt; int M, N, K; };

struct StaticOrder {
    int nM, nN, nwg, G, c;
    __host__ __device__ void init(int M, int N, int G_, int c_) { nM = M / BM; nN = N / BM; nwg = nM * nN; G = G_; c = c_; }
    __host__ __device__ bool next(int i, Unit& u) const {
        const long L = (long)i * G + c; if (L >= nwg) return false;
        int wgid = (int)L; { const int q = nwg / NXCD, r = nwg % NXCD, xcd = wgid % NXCD, off = wgid / NXCD; wgid = (xcd < r ? xcd * (q + 1) : r * (q + 1) + (xcd - r) * q) + off; }
        const int nig = WGM * nN, gid = wgid / nig, fm = gid * WGM, gsz = (nM - fm) < WGM ? (nM - fm) : WGM;
        u.pm = fm + ((wgid % nig) % gsz); u.pn = (wgid % nig) / gsz; return true;
    }
    __device__ __forceinline__ void a_ready(const Unit&) const {}
    __device__ __forceinline__ void done(const Unit&) const {}
};

__device__ __forceinline__ unsigned cvt_pk_bf16(float lo, float hi) { typedef float f32x2_t __attribute__((ext_vector_type(2))); typedef __bf16 bf16x2_t __attribute__((ext_vector_type(2)));
    f32x2_t v = {lo, hi}; bf16x2_t b = __builtin_convertvector(v, bf16x2_t); return __builtin_bit_cast(unsigned, b); }
__device__ __forceinline__ void unpack8(const u32x4 w, float (&f)[8]) {
    f[0] = __uint_as_float(w.x << 16); f[1] = __uint_as_float(w.x & 0xffff0000u); f[2] = __uint_as_float(w.y << 16); f[3] = __uint_as_float(w.y & 0xffff0000u);
    f[4] = __uint_as_float(w.z << 16); f[5] = __uint_as_float(w.z & 0xffff0000u); f[6] = __uint_as_float(w.w << 16); f[7] = __uint_as_float(w.w & 0xffff0000u); }
__device__ __forceinline__ u32x4 pack8(const float (&f)[8]) { u32x4 w; w.x = cvt_pk_bf16(f[0], f[1]); w.y = cvt_pk_bf16(f[2], f[3]); w.z = cvt_pk_bf16(f[4], f[5]); w.w = cvt_pk_bf16(f[6], f[7]); return w; }
__device__ __forceinline__ float sigmoid_f(float x) { return __builtin_amdgcn_rcpf(1.f + __builtin_amdgcn_exp2f(-x * LOG2E)); }

struct EpiQKV {
    static constexpr bool PERM = true, AFTER_DRAIN = false;
    bf16_t* base;
    __device__ __forceinline__ void operator()(const f32x4 (&acc)[2][2][4][2], const Unit& u, int wr, int wc, int fr, int fq) const {
        const int row0 = u.pm * BM + wr * 64 + fr;
        bf16_t* b = base + (size_t)(u.pn >> 1) * ((size_t)MTOK * 512);
        const float sc = u.pn < 6 ? QSCALE : 1.f;
        const int col0 = (u.pn & 1) * 256 + wc * 32 + 8 * fq;
#pragma unroll
        for (int ai = 0; ai < 2; ++ai)
#pragma unroll
            for (int m = 0; m < 4; ++m) { bf16_t* rowp = b + (size_t)(row0 + ai * HALF + m * 16) * 512 + col0;
#pragma unroll
                for (int bj = 0; bj < 2; ++bj) { f32x4 v0 = acc[ai][bj][m][0], v1 = acc[ai][bj][m][1]; asm volatile("" : "+v"(v0), "+v"(v1)); v0 = v0 * sc; v1 = v1 * sc;
                    float f[8] = {v0[0], v0[1], v0[2], v0[3], v1[0], v1[1], v1[2], v1[3]};
                    *(u32x4*)(rowp + bj * HALF) = pack8(f); }
                asm volatile("" ::: "memory"); }
    }
};

struct EpiZG {
    static constexpr bool PERM = true, AFTER_DRAIN = false;
    bf16_t* qkv; bf16_t* gates; const bf16_t* dilo; const float* lse;
    __device__ __forceinline__ void operator()(const f32x4 (&acc)[2][2][4][2], const Unit& u, int wr, int wc, int fr, int fq) const {
        const int row0 = u.pm * BM + wr * 64 + fr;
        if (u.pn < 4) {
            bf16_t* yb = qkv + (size_t)(u.pn >> 1) * ((size_t)MTOK * 512);
            const unsigned off0 = (unsigned)row0 * 512u + (unsigned)((u.pn & 1) * 256 + wc * 32 + 8 * fq);
#pragma unroll
            for (int ai = 0; ai < 2; ++ai) {
                u32x4 ov[4][2];
#pragma unroll
                for (int m = 0; m < 4; ++m)
#pragma unroll
                    for (int bj = 0; bj < 2; ++bj) ov[m][bj] = *(const u32x4*)(yb + off0 + (unsigned)((ai * HALF + m * 16) * 512 + bj * HALF));
                asm volatile("" ::: "memory");
#pragma unroll
                for (int m = 0; m < 4; ++m) {
#pragma unroll
                    for (int bj = 0; bj < 2; ++bj) { const unsigned off = off0 + (unsigned)((ai * HALF + m * 16) * 512 + bj * HALF); float o[8];
                        unpack8(ov[m][bj], o);
                        const f32x4 z0 = acc[ai][bj][m][0], z1 = acc[ai][bj][m][1];
                        f32x4 e0 = z0 * (-LOG2E), e1 = z1 * (-LOG2E); asm volatile("" : "+v"(e0), "+v"(e1));
#pragma unroll
                        for (int i = 0; i < 4; ++i) { e0[i] = __builtin_amdgcn_exp2f(e0[i]); e1[i] = __builtin_amdgcn_exp2f(e1[i]); }
                        e0 = e0 + 1.f; e1 = e1 + 1.f; asm volatile("" : "+v"(e0), "+v"(e1));
#pragma unroll
                        for (int i = 0; i < 4; ++i) { e0[i] = __builtin_amdgcn_rcpf(e0[i]); e1[i] = __builtin_amdgcn_rcpf(e1[i]); }
                        const f32x4 o0 = {o[0], o[1], o[2], o[3]}, o1 = {o[4], o[5], o[6], o[7]};
                        const f32x4 y0 = (o0 * z0) * e0, y1 = (o1 * z1) * e1;
                        const float y[8] = {y0[0], y0[1], y0[2], y0[3], y1[0], y1[1], y1[2], y1[3]};
                        *(u32x4*)(yb + off) = pack8(y); }
                    asm volatile("" ::: "memory"); } }
        } else if (u.pn < 6) {
            bf16_t* yb = qkv + (size_t)2 * ((size_t)MTOK * 512);
            const unsigned off0 = (unsigned)row0 * 512u + (unsigned)((u.pn & 1) * 256 + wc * 32 + 8 * fq);
            const int hd0 = (u.pn & 1) * 4 + (wc >> 1);
#pragma unroll
            for (int ai = 0; ai < 2; ++ai)
#pragma unroll
                for (int m = 0; m < 4; ++m) {
                    u32x4 dv[2][3]; float lv[2][3]; const int rr = ai * HALF + m * 16;
#pragma unroll
                    for (int bj = 0; bj < 2; ++bj) { const unsigned off = off0 + (unsigned)(rr * 512 + bj * HALF);
#pragma unroll
                        for (int p = 0; p < 3; ++p) { dv[bj][p] = *(const u32x4*)(dilo + (size_t)p * ((size_t)MTOK * 512) + off); lv[bj][p] = lse[((size_t)p * MTOK + (size_t)(row0 + rr)) * 8 + hd0 + 2 * bj]; } }
                    asm volatile("" ::: "memory");
#pragma unroll
                    for (int bj = 0; bj < 2; ++bj) { const unsigned off = off0 + (unsigned)(rr * 512 + bj * HALF);
                        const float l0 = lv[bj][0], l1 = lv[bj][1], l2 = lv[bj][2]; const float mx = fmaxf(fmaxf(l0, l1), l2);
                        float w0 = __builtin_amdgcn_exp2f(l0 - mx), w1 = __builtin_amdgcn_exp2f(l1 - mx), w2 = __builtin_amdgcn_exp2f(l2 - mx);
                        const float inv = 1.f / (w0 + w1 + w2); w0 *= inv; w1 *= inv; w2 *= inv;
                        float a0[8], a1[8], a2[8]; unpack8(dv[bj][0], a0); unpack8(dv[bj][1], a1); unpack8(dv[bj][2], a2);
                        const f32x4 z0 = acc[ai][bj][m][0], z1 = acc[ai][bj][m][1];
                        f32x4 e0 = z0 * (-LOG2E), e1 = z1 * (-LOG2E); asm volatile("" : "+v"(e0), "+v"(e1));
#pragma unroll
                        for (int i = 0; i < 4; ++i) { e0[i] = __builtin_amdgcn_exp2f(e0[i]); e1[i] = __builtin_amdgcn_exp2f(e1[i]); }
                        e0 = e0 + 1.f; e1 = e1 + 1.f; asm volatile("" : "+v"(e0), "+v"(e1));
#pragma unroll
                        for (int i = 0; i < 4; ++i) { e0[i] = __builtin_amdgcn_rcpf(e0[i]); e1[i] = __builtin_amdgcn_rcpf(e1[i]); }
                        const f32x4 o0 = (f32x4){a0[0], a0[1], a0[2], a0[3]} * w0 + (f32x4){a1[0], a1[1], a1[2], a1[3]} * w1 + (f32x4){a2[0], a2[1], a2[2], a2[3]} * w2;
                        const f32x4 o1 = (f32x4){a0[4], a0[5], a0[6], a0[7]} * w0 + (f32x4){a1[4], a1[5], a1[6], a1[7]} * w1 + (f32x4){a2[4], a2[5], a2[6], a2[7]} * w2;
                        const f32x4 y0 = (o0 * z0) * e0, y1 = (o1 * z1) * e1;
                        const float y[8] = {y0[0], y0[1], y0[2], y0[3], y1[0], y1[1], y1[2], y1[3]};
                        *(u32x4*)(yb + off) = pack8(y); }
                    asm volatile("" ::: "memory"); }
        } else {
            const unsigned off0 = (unsigned)row0 * 3072u + (unsigned)((u.pn - 6) * 256 + wc * 32 + 8 * fq);
#pragma unroll
            for (int ai = 0; ai < 2; ++ai)
#pragma unroll
                for (int m = 0; m < 4; ++m) {
#pragma unroll
                    for (int bj = 0; bj < 2; ++bj) { const unsigned off = off0 + (unsigned)((ai * HALF + m * 16) * 3072 + bj * HALF);
                        f32x4 e0 = acc[ai][bj][m][0] * (-LOG2E), e1 = acc[ai][bj][m][1] * (-LOG2E); asm volatile("" : "+v"(e0), "+v"(e1));
#pragma unroll
                        for (int i = 0; i < 4; ++i) { e0[i] = __builtin_amdgcn_exp2f(e0[i]); e1[i] = __builtin_amdgcn_exp2f(e1[i]); }
                        e0 = e0 + 1.f; e1 = e1 + 1.f; asm volatile("" : "+v"(e0), "+v"(e1));
                        float g[8] = {__builtin_amdgcn_rcpf(e0[0]), __builtin_amdgcn_rcpf(e0[1]), __builtin_amdgcn_rcpf(e0[2]), __builtin_amdgcn_rcpf(e0[3]), __builtin_amdgcn_rcpf(e1[0]), __builtin_amdgcn_rcpf(e1[1]), __builtin_amdgcn_rcpf(e1[2]), __builtin_amdgcn_rcpf(e1[3])};
                        *(u32x4*)(gates + off) = pack8(g); }
                    asm volatile("" ::: "memory"); }
        }
    }
};

template <int NBR> struct EpiBranch {
    static constexpr bool PERM = true, AFTER_DRAIN = false;
    const bf16_t* gates; bf16_t* merged;
    __device__ __forceinline__ void operator()(const f32x4 (&acc)[2][2][4][2], const Unit& u, int wr, int wc, int fr, int fq) const {
        const int row0 = u.pm * BM + wr * 64 + fr; const int col0 = u.pn * BM + wc * 32 + 8 * fq;
#pragma unroll
        for (int ai = 0; ai < 2; ++ai) {
            u32x4 gv[4][2], mv[4][2];
#pragma unroll
            for (int m = 0; m < 4; ++m)
#pragma unroll
                for (int bj = 0; bj < 2; ++bj) { const int row = row0 + ai * HALF + m * 16, col = col0 + bj * HALF;
                    gv[m][bj] = *(const u32x4*)(gates + (size_t)row * 3072 + NBR * 1024 + col);
                    if (NBR > 0) mv[m][bj] = *(const u32x4*)(merged + (size_t)row * 1024 + col); }
            asm volatile("" ::: "memory");
#pragma unroll
            for (int m = 0; m < 4; ++m) { const int row = row0 + ai * HALF + m * 16;
#pragma unroll
                for (int bj = 0; bj < 2; ++bj) { const int col = col0 + bj * HALF;
                    float g[8]; unpack8(gv[m][bj], g);
                    f32x4 v0 = acc[ai][bj][m][0], v1 = acc[ai][bj][m][1]; asm volatile("" : "+v"(v0), "+v"(v1));
                    float r[8] = {g[0] * v0[0], g[1] * v0[1], g[2] * v0[2], g[3] * v0[3], g[4] * v1[0], g[5] * v1[1], g[6] * v1[2], g[7] * v1[3]};
                    bf16_t* mp = merged + (size_t)row * 1024 + col;
                    if (NBR > 0) { float old[8]; unpack8(mv[m][bj], old);
#pragma unroll
                        for (int i = 0; i < 8; ++i) r[i] += old[i]; }
                    *(u32x4*)mp = pack8(r); }
                asm volatile("" ::: "memory"); } }
    }
};

struct EpiOut {
    static constexpr bool PERM = false, AFTER_DRAIN = false;
    const float* xin; float* xout;
    __device__ __forceinline__ void operator()(const f32x4 (&acc)[2][2][4][2], const Unit& u, int wr, int wc, int fr, int fq) const {
        const int row0 = u.pm * BM + wr * 64 + fr; const int col0 = u.pn * BM + wc * 32 + 4 * fq;
#pragma unroll
        for (int ai = 0; ai < 2; ++ai) {
            f32x4 xv[4][2][2];
#pragma unroll
            for (int m = 0; m < 4; ++m)
#pragma unroll
                for (int bj = 0; bj < 2; ++bj)
#pragma unroll
                    for (int n = 0; n < 2; ++n) xv[m][bj][n] = *(const f32x4*)(xin + (size_t)(row0 + ai * HALF + m * 16) * 1024 + col0 + bj * HALF + n * 16);
            asm volatile("" ::: "memory");
#pragma unroll
            for (int m = 0; m < 4; ++m) { const size_t off = (size_t)(row0 + ai * HALF + m * 16) * 1024 + col0;
#pragma unroll
                for (int bj = 0; bj < 2; ++bj)
#pragma unroll
                    for (int n = 0; n < 2; ++n) { const size_t o2 = off + bj * HALF + n * 16; *(f32x4*)(xout + o2) = xv[m][bj][n] + acc[ai][bj][m][n]; }
                asm volatile("" ::: "memory"); } }
    }
};


template <class Epi, class Sched, bool ALIGN_EPI = false, bool SP2 = false>
__device__ __forceinline__ void gemm_phase(PG8_LAS unsigned char* lds, const Gemm g, const Sched& S, const Epi& E) {
    int tid_l = threadIdx.x; asm volatile("" : "+v"(tid_l));
    const int tid = tid_l, wid = __builtin_amdgcn_readfirstlane(tid >> 6), lane = tid & 63, wr = wid >> 2, wc = wid & 3, fr = lane & 15, fq = lane >> 4;
    const int K = g.K, nt = K / BK;
    unsigned voffA[2], voffB[2];
#pragma unroll
    for (int i = 0; i < 2; ++i) { int R, C; stage_rc(tid * 16 + i * 8192, R, C); const int Rb = Epi::PERM ? ((R & ~31) + perm32(R & 31)) : R;
        voffA[i] = (unsigned)(R * K + C) * 2u; voffB[i] = (unsigned)(Rb * K + C) * 2u; }
    const size_t kstep = (size_t)(BK * 2);
    const size_t hstep = (size_t)HALF * K * 2;
    const size_t tstep = 2 * hstep;
    const unsigned ldsw = (unsigned)wid * 1024u;
    const int aoff = lds_byte(wr * 64 + fr, fq * 8), boff = lds_byte(wc * 32 + fr, fq * 8);
#define PG8_SA(b, h) (((b) * 2 + (h)) * HTB)
#define PG8_SB(b, h) ((4 + (b) * 2 + (h)) * HTB)
#define PG8_STAGE(bufoff, gbase, voff) do { _Pragma("unroll") for (int _i = 0; _i < 2; ++_i) \
        __builtin_amdgcn_global_load_lds((const unsigned*)((const char*)(gbase) + (voff)[_i]), (PG8_LAS unsigned*)(lds + (bufoff) + ldsw + _i * 8192), 16, 0, 0); } while (0)
#define PG8_LDA(dst, b, h) do { _Pragma("unroll") for (int m = 0; m < 4; ++m) _Pragma("unroll") for (int k = 0; k < 2; ++k) dst[m][k] = *(const PG8_LAS bf16x8*)(lds + PG8_SA(b, h) + aoff + m * 2048 + k * 1024); } while (0)
#define PG8_LDB(dst, b, h) do { _Pragma("unroll") for (int n = 0; n < 2; ++n) _Pragma("unroll") for (int k = 0; k < 2; ++k) dst[n][k] = *(const PG8_LAS bf16x8*)(lds + PG8_SB(b, h) + boff + n * 2048 + k * 1024); } while (0)
#define PG8_MMA(ai, bj, At, Bt) do { __builtin_amdgcn_s_setprio(1); _Pragma("unroll") for (int m = 0; m < 4; ++m) _Pragma("unroll") for (int n = 0; n < 2; ++n) _Pragma("unroll") for (int k = 0; k < 2; ++k) \
        acc[ai][bj][m][n] = __builtin_amdgcn_mfma_f32_16x16x32_bf16(Bt[n][k], At[m][k], acc[ai][bj][m][n], 0, 0, 0); __builtin_amdgcn_s_setprio(0); } while (0)
#define PG8_WAIT_V(n) asm volatile("s_waitcnt vmcnt(" #n ")" ::: "memory")
#define PG8_WAIT_L(n) asm volatile("s_waitcnt lgkmcnt(" #n ")" ::: "memory")
#define PG8_BAR __builtin_amdgcn_s_barrier()
#define PG8_SCHED __builtin_amdgcn_sched_barrier(0)
    Unit cur, nxt; int ui = 0;
    if (!S.next(0, cur)) return;
    f32x4 acc[2][2][4][2];
#pragma unroll
    for (int a = 0; a < 2; ++a)
#pragma unroll
        for (int b = 0; b < 2; ++b)
#pragma unroll
            for (int m = 0; m < 4; ++m)
#pragma unroll
                for (int n = 0; n < 2; ++n) acc[a][b][m][n] = (f32x4){0.f, 0.f, 0.f, 0.f};
    bf16x8 At[4][2], B0[2][2], B1[2][2];
    const char* cA = (const char*)g.A + (size_t)cur.pm * tstep; const char* cB = (const char*)g.Bt + (size_t)cur.pn * tstep;
    S.a_ready(cur);
    if constexpr (SP2) {
        PG8_STAGE(PG8_SB(0, 0), cB, voffB); PG8_STAGE(PG8_SB(0, 1), cB + hstep, voffB); PG8_STAGE(PG8_SA(0, 0), cA, voffA); PG8_STAGE(PG8_SA(0, 1), cA + hstep, voffA);
        if (wr == 1) PG8_BAR;
        PG8_WAIT_V(2); PG8_BAR;
        PG8_STAGE(PG8_SB(1, 0), cB + kstep, voffB); PG8_STAGE(PG8_SA(1, 0), cA + kstep, voffA); PG8_STAGE(PG8_SB(1, 1), cB + hstep + kstep, voffB);
        PG8_WAIT_V(6); PG8_BAR;
    } else {
        PG8_STAGE(PG8_SB(0, 0), cB, voffB); PG8_STAGE(PG8_SA(0, 0), cA, voffA); PG8_STAGE(PG8_SB(0, 1), cB + hstep, voffB); PG8_STAGE(PG8_SA(0, 1), cA + hstep, voffA);
        if (wr == 1) PG8_BAR;
        PG8_WAIT_V(4); PG8_BAR;
        PG8_STAGE(PG8_SB(1, 0), cB + kstep, voffB); PG8_STAGE(PG8_SA(1, 0), cA + kstep, voffA); PG8_STAGE(PG8_SB(1, 1), cB + hstep + kstep, voffB);
        PG8_WAIT_V(6); PG8_BAR;
    }
    for (;;) {
        const bool has_next = S.next(ui + 1, nxt);
        const char* nA = has_next ? (const char*)g.A + (size_t)nxt.pm * tstep : cA; const char* nB = has_next ? (const char*)g.Bt + (size_t)nxt.pn * tstep : cB;
        for (int t = 0; t < nt; t += 2) {
            const bool last = (t == nt - 2);
            const char* a1 = cA + (size_t)(t + 1) * kstep;
            const char* a2 = last ? nA : cA + (size_t)(t + 2) * kstep; const char* b2 = last ? nB : cB + (size_t)(t + 2) * kstep;
            const char* a3 = a2 + kstep; const char* b3 = b2 + kstep;
            if (last && has_next) S.a_ready(nxt);
            if constexpr (SP2) {
            PG8_LDB(B0, 0, 0); PG8_LDB(B1, 0, 1); PG8_SCHED; PG8_LDA(At, 0, 0); PG8_STAGE(PG8_SA(1, 1), a1 + hstep, voffA);
            PG8_WAIT_V(8); PG8_WAIT_L(0); PG8_BAR; PG8_MMA(0, 0, At, B0); PG8_MMA(0, 1, At, B1); PG8_BAR; PG8_SCHED;
            PG8_LDA(At, 0, 1); PG8_STAGE(PG8_SB(0, 0), b2, voffB); PG8_STAGE(PG8_SB(0, 1), b2 + hstep, voffB); PG8_STAGE(PG8_SA(0, 0), a2, voffA);
            PG8_WAIT_V(8); PG8_WAIT_L(0); PG8_BAR; PG8_MMA(1, 0, At, B0); PG8_MMA(1, 1, At, B1); PG8_BAR; PG8_SCHED;
            PG8_LDB(B0, 1, 0); PG8_LDB(B1, 1, 1); PG8_SCHED; PG8_LDA(At, 1, 0); PG8_STAGE(PG8_SA(0, 1), a2 + hstep, voffA);
            PG8_WAIT_V(8); PG8_WAIT_L(0); PG8_BAR; PG8_MMA(0, 0, At, B0); PG8_MMA(0, 1, At, B1); PG8_BAR; PG8_SCHED;
            PG8_LDA(At, 1, 1); PG8_STAGE(PG8_SB(1, 0), b3, voffB); PG8_STAGE(PG8_SB(1, 1), b3 + hstep, voffB); PG8_STAGE(PG8_SA(1, 0), a3, voffA);
            PG8_WAIT_V(8); PG8_WAIT_L(0); PG8_BAR; PG8_MMA(1, 0, At, B0); PG8_MMA(1, 1, At, B1); PG8_BAR; PG8_SCHED;
            } else {
            PG8_LDB(B0, 0, 0); PG8_SCHED; PG8_LDA(At, 0, 0); PG8_STAGE(PG8_SA(1, 1), a1 + hstep, voffA);
            PG8_WAIT_L(8); PG8_BAR; PG8_WAIT_L(0); PG8_MMA(0, 0, At, B0); PG8_BAR; PG8_SCHED;
            PG8_LDB(B1, 0, 1); PG8_STAGE(PG8_SB(0, 0), b2, voffB);
            PG8_BAR; PG8_WAIT_L(0); PG8_MMA(0, 1, At, B1); PG8_BAR;
            PG8_LDA(At, 0, 1); PG8_STAGE(PG8_SA(0, 0), a2, voffA);
            PG8_BAR; PG8_WAIT_L(0); PG8_MMA(1, 0, At, B0); PG8_BAR; PG8_SCHED;
            PG8_STAGE(PG8_SB(0, 1), b2 + hstep, voffB);
            PG8_WAIT_V(6); PG8_BAR; PG8_MMA(1, 1, At, B1); PG8_BAR;
            PG8_LDB(B0, 1, 0); PG8_SCHED; PG8_LDA(At, 1, 0); PG8_STAGE(PG8_SA(0, 1), a2 + hstep, voffA);
            PG8_WAIT_L(8); PG8_BAR; PG8_WAIT_L(0); PG8_MMA(0, 0, At, B0); PG8_BAR; PG8_SCHED;
            PG8_LDB(B1, 1, 1); PG8_STAGE(PG8_SB(1, 0), b3, voffB);
            PG8_BAR; PG8_WAIT_L(0); PG8_MMA(0, 1, At, B1); PG8_BAR;
            PG8_LDA(At, 1, 1); PG8_STAGE(PG8_SA(1, 0), a3, voffA);
            PG8_BAR; PG8_WAIT_L(0); PG8_MMA(1, 0, At, B0); PG8_BAR; PG8_SCHED;
            PG8_STAGE(PG8_SB(1, 1), b3 + hstep, voffB);
            PG8_WAIT_V(6); PG8_BAR; PG8_MMA(1, 1, At, B1); PG8_BAR;
            }
        }
        if constexpr (ALIGN_EPI) { if (wr == 0) PG8_BAR; }
        if constexpr (!Epi::AFTER_DRAIN) { E(acc, cur, wr, wc, fr, fq); S.done(cur); }
        if (!has_next) break;
#pragma unroll
        for (int a = 0; a < 2; ++a)
#pragma unroll
            for (int b = 0; b < 2; ++b)
#pragma unroll
                for (int m = 0; m < 4; ++m)
#pragma unroll
                    for (int n = 0; n < 2; ++n) acc[a][b][m][n] = (f32x4){0.f, 0.f, 0.f, 0.f};
        cur = nxt; cA = nA; cB = nB; ++ui;
        if constexpr (ALIGN_EPI) { if (wr == 1) PG8_BAR; }
    }
    PG8_WAIT_V(0);
    if constexpr (!ALIGN_EPI) { if (wr == 0) PG8_BAR; }
    PG8_BAR;
    if constexpr (Epi::AFTER_DRAIN) { E.fused(acc, cur, wr, wc, fr, fq, lds, wid, lane); S.done(cur); }
#undef PG8_SA
#undef PG8_SB
#undef PG8_STAGE
#undef PG8_LDA
#undef PG8_LDB
#undef PG8_MMA
#undef PG8_WAIT_V
#undef PG8_WAIT_L
#undef PG8_BAR
#undef PG8_SCHED
}
}

namespace att {
#define LAS __attribute__((address_space(3)))
typedef unsigned short bf16_t;
typedef short bf16x8 __attribute__((ext_vector_type(8)));
typedef short s16x4 __attribute__((ext_vector_type(4)));
typedef short v4i16_t __attribute__((ext_vector_type(4)));
typedef float f32x16 __attribute__((ext_vector_type(16)));
typedef float f32x4 __attribute__((ext_vector_type(4)));
typedef unsigned u32x4 __attribute__((ext_vector_type(4)));
typedef unsigned u32x2 __attribute__((ext_vector_type(2)));
constexpr int L_K = 0, L_V = 16384, L_B = 49152, L_MISC = 49152 + 512;
constexpr float ATT_THR = 64.f;
constexpr int L2_K = 0, L2_V = 32768;
constexpr int L_OA = 65536;
constexpr int ATT_LDS_BYTES = L_OA + 65536;

__device__ __forceinline__ int crow(int r, int hi) { return (r & 3) + 8 * (r >> 2) + 4 * hi; }
__device__ __forceinline__ unsigned cvtpk(float lo, float hi) { typedef float f32x2_t __attribute__((ext_vector_type(2))); typedef __bf16 bf16x2_t __attribute__((ext_vector_type(2)));
    f32x2_t v = {lo, hi}; bf16x2_t b = __builtin_convertvector(v, bf16x2_t); return __builtin_bit_cast(unsigned, b); }
__device__ __forceinline__ s16x4 vtr(const LAS char* p) { return __builtin_bit_cast(s16x4, __builtin_amdgcn_ds_read_tr16_b64_v4i16((LAS v4i16_t*)p)); }
typedef float f32x8_t __attribute__((ext_vector_type(8))); typedef float f32x4_t __attribute__((ext_vector_type(4))); typedef float f32x2_t __attribute__((ext_vector_type(2)));
__device__ __forceinline__ float hsum16(const f32x16 s) {
    const f32x8_t a = __builtin_shufflevector(s, s, 0, 1, 2, 3, 4, 5, 6, 7) + __builtin_shufflevector(s, s, 8, 9, 10, 11, 12, 13, 14, 15);
    const f32x4_t b = __builtin_shufflevector(a, a, 0, 1, 2, 3) + __builtin_shufflevector(a, a, 4, 5, 6, 7);
    const f32x2_t c = __builtin_shufflevector(b, b, 0, 1) + __builtin_shufflevector(b, b, 2, 3);
    return c[0] + c[1]; }
__device__ __forceinline__ float half_max(float v) { auto rr = __builtin_amdgcn_permlane32_swap(__float_as_uint(v), __float_as_uint(v), false, false); return fmaxf(__uint_as_float(rr[0]), __uint_as_float(rr[1])); }
__device__ __forceinline__ float half_sum(float v) { auto rr = __builtin_amdgcn_permlane32_swap(__float_as_uint(v), __float_as_uint(v), false, false); return __uint_as_float(rr[0]) + __uint_as_float(rr[1]); }
#define MFMA32(a, b, c) __builtin_amdgcn_mfma_f32_32x32x16_bf16(a, b, c, 0, 0, 0)

struct PassArgs {
    const bf16_t* q;
    const bf16_t* k;
    const bf16_t* v;
    long kpitch;
    const float* kbias;
    float qbias;
    float slope2;
    int q0;
};

template <int DV, int MODE>
__device__ __forceinline__ void attn_pass(LAS char* lds, const PassArgs& a, f32x16 (&o)[DV / 32], float& m_out, float& l_out, const int tid) {
    const int lane = tid & 63, r32 = lane & 31, hi = lane >> 5;
    const int w = __builtin_amdgcn_readfirstlane(tid >> 6);
    const int qw0 = a.q0 + 32 * w, myq = qw0 + r32;
    const int t_begin = (MODE == 2 && a.q0 >= 256) ? ((a.q0 - 128) >> 6) : 0;
    const int t_end = (a.q0 + 256) >> 6;
    const int tw_hi = (qw0 + 31) >> 6;
    const int tw_lo = (MODE == 2 && qw0 > 128) ? ((qw0 - 128) >> 6) : 0;
    bf16x8 qf[4];
#pragma unroll
    for (int d0 = 0; d0 < 4; ++d0) qf[d0] = *(const bf16x8*)(a.q + d0 * 16 + hi * 8);
#pragma unroll
    for (int i = 0; i < DV / 32; ++i)
#pragma unroll
        for (int g = 0; g < 16; ++g) o[i][g] = 0.f;
    float m = -1e30f, l = 0.f;
    f32x16 kc;
#pragma unroll
    for (int g = 0; g < 16; ++g) kc[g] = (MODE == 1) ? 0.f : a.slope2 * (float)((g & 3) + 8 * (g >> 2) + 4 * hi);
    const bf16_t* ksrc = a.k + (long)lane * a.kpitch + 8 * w;
    const bf16_t* vsrc = a.v + (long)(16 * (w & 3) + (lane >> 2)) * a.kpitch + 32 * (w >> 2) + 8 * (lane & 3);
    const long tstride = 64 * a.kpitch;
#define ATT_ISSUE(t, buf) do { \
        __builtin_amdgcn_global_load_lds((const unsigned*)(ksrc + (long)(t) * tstride), (LAS unsigned*)(lds + L_K + (buf) * 8192 + w * 1024), 16, 0, 0); \
        __builtin_amdgcn_global_load_lds((const unsigned*)(vsrc + (long)(t) * tstride), (LAS unsigned*)(lds + L_V + (buf) * 16384 + w * 1024), 16, 0, 0); \
        if (DV == 128) __builtin_amdgcn_global_load_lds((const unsigned*)(vsrc + (long)(t) * tstride + 64), (LAS unsigned*)(lds + L_V + (buf) * 16384 + (w + 8) * 1024), 16, 0, 0); \
        if (MODE == 1) { if (w == 0) __builtin_amdgcn_global_load_lds((const unsigned*)(a.kbias + (t) * 64 + lane), (LAS unsigned*)(lds + L_B + (buf) * 256), 4, 0, 0); } \
    } while (0)
    ATT_ISSUE(t_begin, 0);
    __syncthreads();
    const int vlane = ((lane >> 4) & 1) * 32 + (lane & 3) * 8 + (4 * hi + ((lane & 15) >> 2)) * 64;
    for (int t = t_begin; t < t_end; ++t) {
        const int buf = (t - t_begin) & 1;
        if (t + 1 < t_end) ATT_ISSUE(t + 1, buf ^ 1);
        if (t >= tw_lo && t <= tw_hi) {
            const LAS char* kb = lds + L_K + buf * 8192 + hi * 1024 + r32 * 16;
            f32x16 p0, p1;
#pragma unroll
            for (int d0 = 0; d0 < 4; ++d0) {
                const bf16x8 k0 = *(const LAS bf16x8*)(kb + d0 * 2048), k1 = *(const LAS bf16x8*)(kb + d0 * 2048 + 512);
                if (d0 == 0) { p0 = MFMA32(k0, qf[0], kc); p1 = MFMA32(k1, qf[0], kc); }
                else { p0 = MFMA32(k0, qf[d0], p0); p1 = MFMA32(k1, qf[d0], p1); }
            }
            __builtin_amdgcn_sched_barrier(0);
            float base, c32 = 0.f;
            if (MODE == 1) {
                const LAS char* bb = lds + L_B + buf * 256 + hi * 16;
#pragma unroll
                for (int gq = 0; gq < 4; ++gq) {
                    const f32x4 c0 = *(const LAS f32x4*)(bb + gq * 32), c1 = *(const LAS f32x4*)(bb + 128 + gq * 32);
#pragma unroll
                    for (int j = 0; j < 4; ++j) { p0[4 * gq + j] -= c0[j]; p1[4 * gq + j] -= c1[j]; }
                }
                base = a.qbias;
            } else {
                base = a.slope2 * (float)(64 * t - myq); c32 = 32.f * a.slope2;
            }
            const bool bnd = (64 * t + 63 > qw0) || (MODE == 2 && 64 * t < qw0 + 31 - 128);
            if (bnd) {
                const int dq = myq - 64 * t - 4 * hi;
#pragma unroll
                for (int g = 0; g < 16; ++g) {
                    const int cg = (g & 3) + 8 * (g >> 2);
                    const bool v0 = MODE == 2 ? ((unsigned)(dq - cg) <= 128u) : (cg <= dq);
                    const bool v1 = MODE == 2 ? ((unsigned)(dq - cg - 32) <= 128u) : (cg + 32 <= dq);
                    p0[g] = v0 ? p0[g] : -INFINITY; p1[g] = v1 ? p1[g] : -INFINITY;
                }
            }
            float mx0 = p0[0], mx1 = p1[0];
#pragma unroll
            for (int g = 1; g < 16; ++g) { mx0 = fmaxf(mx0, p0[g]); mx1 = fmaxf(mx1, p1[g]); }
            float mx = half_max(fmaxf(mx0, mx1 + c32));
            const float mt_ = mx + base; const float mnew = (mt_ > m + ATT_THR) ? mt_ : m;
            const float alpha = __builtin_amdgcn_exp2f(m - mnew);
            const float mb = mnew - base, mb1 = mb - c32;
            { float nmb = -mb, nmb1 = -mb1; asm volatile("" : "+v"(nmb), "+v"(nmb1)); p0 = p0 + nmb; p1 = p1 + nmb1; }
#pragma unroll
            for (int g = 0; g < 16; ++g) { p0[g] = __builtin_amdgcn_exp2f(p0[g]); p1[g] = __builtin_amdgcn_exp2f(p1[g]); }
            const float ps = hsum16(p0 + p1);
            l = l * alpha + ps;
            if (__any(mnew > m)) {
#pragma unroll
                for (int i = 0; i < DV / 32; ++i)
#pragma unroll
                    for (int g = 0; g < 16; ++g) o[i][g] *= alpha;
            }
            m = mnew;
            u32x4 pw[4];
#pragma unroll
            for (int j = 0; j < 4; ++j) { pw[0][j] = cvtpk(p0[2 * j], p0[2 * j + 1]); pw[1][j] = cvtpk(p0[8 + 2 * j], p0[9 + 2 * j]); pw[2][j] = cvtpk(p1[2 * j], p1[2 * j + 1]); pw[3][j] = cvtpk(p1[8 + 2 * j], p1[9 + 2 * j]); }
            __builtin_amdgcn_sched_barrier(0);
            const LAS char* vb = lds + L_V + buf * 16384 + vlane;
            s16x4 lo_[2][DV / 32], hh_[2][DV / 32];
#pragma unroll
            for (int i = 0; i < DV / 32; ++i) { lo_[0][i] = vtr(vb + i * 4096); hh_[0][i] = vtr(vb + i * 4096 + 512); }
#pragma unroll
            for (int ks = 0; ks < 4; ++ks) {
                if (ks + 1 < 4) {
#pragma unroll
                    for (int i = 0; i < DV / 32; ++i) { lo_[(ks + 1) & 1][i] = vtr(vb + i * 4096 + (ks + 1) * 1024); hh_[(ks + 1) & 1][i] = vtr(vb + i * 4096 + (ks + 1) * 1024 + 512); }
                }
#pragma unroll
                for (int i = 0; i < DV / 32; ++i) { const s16x4 lo = lo_[ks & 1][i], hh = hh_[ks & 1][i]; const bf16x8 vf = (bf16x8){lo[0], lo[1], lo[2], lo[3], hh[0], hh[1], hh[2], hh[3]};
                    o[i] = MFMA32(vf, __builtin_bit_cast(bf16x8, pw[ks]), o[i]); }
                __builtin_amdgcn_sched_barrier(0);
            }
        }
        __syncthreads();
    }
#undef ATT_ISSUE
    m_out = m; l_out = l;
}


__device__ __forceinline__ void diff_unit(LAS char* lds, int b, int h, int qb, bf16_t* DQ, const bf16_t* DK, const bf16_t* DVb, float lam, float post, const float* gn) {
    int tid = threadIdx.x; asm volatile("" : "+v"(tid));
    const int lane = tid & 63, r32 = lane & 31, hi = lane >> 5;
    const int w = __builtin_amdgcn_readfirstlane(tid >> 6);
    const int q0 = qb * 256, myq = q0 + 32 * w + r32;
    const size_t tok0 = (size_t)b * SEQ;
    PassArgs a; a.kpitch = 512; a.kbias = nullptr; a.qbias = 0.f; a.q0 = q0;
    a.slope2 = __builtin_amdgcn_exp2f(-2.f * (float)(h + 1)) * LOG2E;
    a.q = DQ + (tok0 + myq) * 512 + (2 * h) * 64; a.k = DK + tok0 * 512 + (2 * h) * 64; a.v = DVb + tok0 * 512 + h * 128;
    f32x16 ob[4]; float m, l;
    LAS u32x4* oas = (LAS u32x4*)(lds + L_OA + w * 8192) + lane;
    attn_pass<128, 0>(lds, a, ob, m, l, tid);
    { const float inv = 1.f / half_sum(l);
#pragma unroll
      for (int i = 0; i < 4; ++i)
#pragma unroll
          for (int jj = 0; jj < 2; ++jj) { u32x4 wv;
#pragma unroll
              for (int j = 0; j < 4; ++j) wv[j] = cvtpk(ob[i][8 * jj + 2 * j] * inv, ob[i][8 * jj + 2 * j + 1] * inv);
              oas[(i * 2 + jj) * 64] = wv; } }
    a.q += 64; a.k += 64;
    attn_pass<128, 0>(lds, a, ob, m, l, tid);
    { const float f = lam / half_sum(l); float ss = 0.f;
#pragma unroll
      for (int i = 0; i < 4; ++i)
#pragma unroll
          for (int jj = 0; jj < 2; ++jj) { const u32x4 wv = oas[(i * 2 + jj) * 64];
#pragma unroll
              for (int j = 0; j < 4; ++j) { const float a0 = __uint_as_float(wv[j] << 16), a1 = __uint_as_float(wv[j] & 0xffff0000u); const int g = 8 * jj + 2 * j;
                  ob[i][g] = a0 - f * ob[i][g]; ob[i][g + 1] = a1 - f * ob[i][g + 1]; ss += ob[i][g] * ob[i][g] + ob[i][g + 1] * ob[i][g + 1]; } }
      ss = half_sum(ss);
      const float rr = post / sqrtf(ss * (1.f / 128.f) + RMS_EPS);
      bf16_t* orow = DQ + (tok0 + myq) * 512 + h * 128;
#pragma unroll
      for (int i = 0; i < 4; ++i)
#pragma unroll
          for (int gq = 0; gq < 4; ++gq) { const int dv0 = 32 * i + 8 * gq + 4 * hi; const f32x4 g4 = *(const f32x4*)(gn + dv0);
              u32x2 wv; wv.x = cvtpk(ob[i][4 * gq] * rr * g4[0], ob[i][4 * gq + 1] * rr * g4[1]); wv.y = cvtpk(ob[i][4 * gq + 2] * rr * g4[2], ob[i][4 * gq + 3] * rr * g4[3]);
              *(u32x2*)(orow + dv0) = wv; } }
}

__device__ __forceinline__ void store_o64(bf16_t* orow, const f32x16 (&o)[2], float inv, int hi) {
#pragma unroll
    for (int i = 0; i < 2; ++i)
#pragma unroll
        for (int gq = 0; gq < 4; ++gq) { const int dv0 = 32 * i + 8 * gq + 4 * hi;
            u32x2 wv; wv.x = cvtpk(o[i][4 * gq] * inv, o[i][4 * gq + 1] * inv); wv.y = cvtpk(o[i][4 * gq + 2] * inv, o[i][4 * gq + 3] * inv);
            *(u32x2*)(orow + dv0) = wv; }
}

__device__ __forceinline__ void fox_unit(LAS char* lds, int b, int h, int qb, bf16_t* FQ, const bf16_t* FK, const bf16_t* FV, const float* cl2) {
    int tid = threadIdx.x; asm volatile("" : "+v"(tid));
    const int lane = tid & 63, r32 = lane & 31, hi = lane >> 5;
    const int w = __builtin_amdgcn_readfirstlane(tid >> 6);
    const int q0 = qb * 256, myq = q0 + 32 * w + r32;
    const size_t tok0 = (size_t)b * SEQ;
    PassArgs a; a.kpitch = 512; a.kbias = cl2; a.qbias = cl2[myq]; a.slope2 = 0.f; a.q0 = q0;
    a.q = FQ + (tok0 + myq) * 512 + h * 64; a.k = FK + tok0 * 512 + h * 64; a.v = FV + tok0 * 512 + h * 64;
    f32x16 o[2]; float m, l;
    attn_pass<64, 1>(lds, a, o, m, l, tid);
    store_o64(FQ + (tok0 + myq) * 512 + h * 64, o, 1.f / half_sum(l), hi);
}

__device__ __forceinline__ void dil_pass2h(LAS char* lds, const PassArgs& a, f32x16 (&o)[2], float& m_out, float& l_out, const int tid) {
    const int lane = tid & 63, r32 = lane & 31, hi = lane >> 5;
    const int w = __builtin_amdgcn_readfirstlane(tid >> 6);
    const int wq = (w & 1) | ((w >> 2) << 1), hs = (w >> 1) & 1;
    const int qw0 = a.q0 + 32 * wq, myq = qw0 + r32;
    const int t_begin = a.q0 >= 128 ? ((a.q0 - 128) >> 6) : 0;
    const int t_end = (a.q0 + 128) >> 6;
    const int tw_hi = (qw0 + 31) >> 6;
    const int tw_lo = qw0 > 128 ? ((qw0 - 128) >> 6) : 0;
    bf16x8 qf[4];
#pragma unroll
    for (int d0 = 0; d0 < 4; ++d0) qf[d0] = *(const bf16x8*)(a.q + d0 * 16 + hi * 8);
#pragma unroll
    for (int i = 0; i < 2; ++i)
#pragma unroll
        for (int g = 0; g < 16; ++g) o[i][g] = 0.f;
    float m = -1e30f, l = 0.f;
    f32x16 kc;
#pragma unroll
    for (int g = 0; g < 16; ++g) kc[g] = a.slope2 * (float)((g & 3) + 8 * (g >> 2) + 4 * hi);
    const bf16_t* ksrc = a.k + (long)lane * a.kpitch + 8 * w;
    const bf16_t* vsrc = a.v + (long)(16 * (w & 3) + (lane >> 2)) * a.kpitch + 32 * (w >> 2) + 8 * (lane & 3);
    const long tstride = 64 * a.kpitch;
#define D2_ISSUE(t, buf) do { \
        __builtin_amdgcn_global_load_lds((const unsigned*)(ksrc + (long)(t) * tstride), (LAS unsigned*)(lds + L2_K + (buf) * 16384 + w * 1024), 16, 0, 0); \
        __builtin_amdgcn_global_load_lds((const unsigned*)(ksrc + (long)(t) * tstride + 64), (LAS unsigned*)(lds + L2_K + (buf) * 16384 + 8192 + w * 1024), 16, 0, 0); \
        __builtin_amdgcn_global_load_lds((const unsigned*)(vsrc + (long)(t) * tstride), (LAS unsigned*)(lds + L2_V + (buf) * 16384 + w * 1024), 16, 0, 0); \
        __builtin_amdgcn_global_load_lds((const unsigned*)(vsrc + (long)(t) * tstride + 64), (LAS unsigned*)(lds + L2_V + (buf) * 16384 + (w + 8) * 1024), 16, 0, 0); \
    } while (0)
    D2_ISSUE(t_begin, 0);
    __syncthreads();
    const int vlane = ((lane >> 4) & 1) * 32 + (lane & 3) * 8 + (4 * hi + ((lane & 15) >> 2)) * 64;
    for (int t = t_begin; t < t_end; ++t) {
        const int buf = (t - t_begin) & 1;
        if (t + 1 < t_end) D2_ISSUE(t + 1, buf ^ 1);
        if (t >= tw_lo && t <= tw_hi) {
            const LAS char* kb = lds + L2_K + buf * 16384 + hs * 8192 + hi * 1024 + r32 * 16;
            f32x16 p0, p1;
#pragma unroll
            for (int d0 = 0; d0 < 4; ++d0) {
                const bf16x8 k0 = *(const LAS bf16x8*)(kb + d0 * 2048), k1 = *(const LAS bf16x8*)(kb + d0 * 2048 + 512);
                if (d0 == 0) { p0 = MFMA32(k0, qf[0], kc); p1 = MFMA32(k1, qf[0], kc); }
                else { p0 = MFMA32(k0, qf[d0], p0); p1 = MFMA32(k1, qf[d0], p1); }
            }
            __builtin_amdgcn_sched_barrier(0);
            const float base = a.slope2 * (float)(64 * t - myq), c32 = 32.f * a.slope2;
            const bool bnd = (64 * t + 63 > qw0) || (64 * t < qw0 + 31 - 128);
            if (bnd) {
                const int dq = myq - 64 * t - 4 * hi;
#pragma unroll
                for (int g = 0; g < 16; ++g) {
                    const int cg = (g & 3) + 8 * (g >> 2);
                    const bool v0 = (unsigned)(dq - cg) <= 128u, v1 = (unsigned)(dq - cg - 32) <= 128u;
                    p0[g] = v0 ? p0[g] : -INFINITY; p1[g] = v1 ? p1[g] : -INFINITY;
                }
            }
            float mx0 = p0[0], mx1 = p1[0];
#pragma unroll
            for (int g = 1; g < 16; ++g) { mx0 = fmaxf(mx0, p0[g]); mx1 = fmaxf(mx1, p1[g]); }
            const float mx = half_max(fmaxf(mx0, mx1 + c32));
            const float mt_ = mx + base; const float mnew = (mt_ > m + ATT_THR) ? mt_ : m;
            const float alpha = __builtin_amdgcn_exp2f(m - mnew);
            const float mb = mnew - base, mb1 = mb - c32;
            { float nmb = -mb, nmb1 = -mb1; asm volatile("" : "+v"(nmb), "+v"(nmb1)); p0 = p0 + nmb; p1 = p1 + nmb1; }
#pragma unroll
            for (int g = 0; g < 16; ++g) { p0[g] = __builtin_amdgcn_exp2f(p0[g]); p1[g] = __builtin_amdgcn_exp2f(p1[g]); }
            const float ps = hsum16(p0 + p1);
            l = l * alpha + ps;
            if (__any(mnew > m)) {
#pragma unroll
                for (int i = 0; i < 2; ++i)
#pragma unroll
                    for (int g = 0; g < 16; ++g) o[i][g] *= alpha;
            }
            m = mnew;
            u32x4 pw[4];
#pragma unroll
            for (int j = 0; j < 4; ++j) { pw[0][j] = cvtpk(p0[2 * j], p0[2 * j + 1]); pw[1][j] = cvtpk(p0[8 + 2 * j], p0[9 + 2 * j]); pw[2][j] = cvtpk(p1[2 * j], p1[2 * j + 1]); pw[3][j] = cvtpk(p1[8 + 2 * j], p1[9 + 2 * j]); }
            __builtin_amdgcn_sched_barrier(0);
            const LAS char* vb = lds + L2_V + buf * 16384 + hs * 8192 + vlane;
#pragma unroll
            for (int ks = 0; ks < 4; ++ks)
#pragma unroll
                for (int i = 0; i < 2; ++i) {
                    const s16x4 lo = vtr(vb + i * 4096 + ks * 1024), hh = vtr(vb + i * 4096 + ks * 1024 + 512);
                    const bf16x8 vf = (bf16x8){lo[0], lo[1], lo[2], lo[3], hh[0], hh[1], hh[2], hh[3]};
                    o[i] = MFMA32(vf, __builtin_bit_cast(bf16x8, pw[ks]), o[i]);
                }
        }
        __syncthreads();
    }
#undef D2_ISSUE
    m_out = m; l_out = l;
}
__device__ __forceinline__ void dil_unit(LAS char* lds, int p, int b, int hp, int r, int blk, const bf16_t* CQ, const bf16_t* CK, const bf16_t* CV, bf16_t* dilo, float* lse) {
    int tid = threadIdx.x; asm volatile("" : "+v"(tid));
    const int lane = tid & 63, r32 = lane & 31, hi = lane >> 5;
    const int w = __builtin_amdgcn_readfirstlane(tid >> 6);
    const int d = 1 << (2 * p), h = 2 * hp + ((w >> 1) & 1);
    const int q0 = blk * 128, myq = q0 + 32 * ((w & 1) | ((w >> 2) << 1)) + r32;
    const size_t tok0 = (size_t)b * SEQ, tok = tok0 + (size_t)myq * d + r;
    PassArgs a; a.kpitch = 512L * d; a.kbias = nullptr; a.qbias = 0.f; a.q0 = q0;
    a.slope2 = __builtin_amdgcn_exp2f(-(float)(h + 1)) * LOG2E * (float)d;
    a.q = CQ + tok * 512 + h * 64; a.k = CK + (tok0 + r) * 512 + hp * 128; a.v = CV + (tok0 + r) * 512 + hp * 128;
    f32x16 o[2]; float m, l;
    dil_pass2h(lds, a, o, m, l, tid);
    const float lt = half_sum(l);
    store_o64(dilo + ((size_t)p * MTOK + tok) * 512 + h * 64, o, 1.f / lt, hi);
    if (hi == 0) lse[((size_t)p * MTOK + tok) * 8 + h] = m + log2f(lt);
}
constexpr int N_DIFF_UNITS = 512, N_FOX_UNITS = 1024, N_DIL_UNITS = 3072, N_ATT_UNITS = N_DIFF_UNITS + N_FOX_UNITS + N_DIL_UNITS;
#undef LAS
}

namespace af {
#define LAS __attribute__((address_space(3)))
typedef unsigned short bf16_t;
using bf16x8=__attribute__((ext_vector_type(8)))short;
using s16x4=__attribute__((ext_vector_type(4)))short;
using f32x16=__attribute__((ext_vector_type(16)))float;
using f32x4=__attribute__((ext_vector_type(4)))float;
using u32x4=__attribute__((ext_vector_type(4)))unsigned;
constexpr int PITCH=512;
constexpr int NW=8,QBLK=32,QB=QBLK*NW,KVBLK=64;
__device__ __forceinline__ int crow(int r,int hi){return (r&3)+8*(r>>2)+4*hi;}
#define SBAR() __builtin_amdgcn_sched_barrier(0)
__device__ __forceinline__ void cmask(f32x16&p0,f32x16&p1,int jb,int qrel,int hi){
  const float NEG=-INFINITY; int kb=64*jb+4*hi;
  #pragma unroll
  for(int r=0;r<16;++r){int kv=kb+(r&3)+8*(r>>2); if(kv>qrel)p0[r]=NEG; if(kv+32>qrel)p1[r]=NEG;}
}
constexpr int NSLOT=3, SLOTB=8192;
constexpr int LDS_K=0, LDS_V=NSLOT*SLOTB, LDS_WS=2*NSLOT*SLOTB, LDS_BIAS=LDS_WS+NW*64*4, LDS_OST=LDS_BIAS+NW*3*256, LDS_MISC=LDS_OST+2*NW*4096, LDS_BYTES=LDS_MISC+64;
__device__ __forceinline__ void glds16(const void*sbase,unsigned voff,unsigned lds_dst){unsigned keep;
  asm volatile("s_mov_b32 %0, m0\n\ts_mov_b32 m0, %3\n\ts_nop 4\n\tglobal_load_lds_dwordx4 %1, %2\n\ts_mov_b32 m0, %0":"=&s"(keep):"v"(voff),"s"(sbase),"s"(lds_dst):"memory");}
__device__ __forceinline__ void glds4(const void*sbase,unsigned voff,unsigned lds_dst){unsigned keep;
  asm volatile("s_mov_b32 %0, m0\n\ts_mov_b32 m0, %3\n\ts_nop 4\n\tglobal_load_lds_dword %1, %2\n\ts_mov_b32 m0, %0":"=&s"(keep):"v"(voff),"s"(sbase),"s"(lds_dst):"memory");}
__device__ __forceinline__ float max3f(float a,float b,float c){float r;asm("v_max3_f32 %0, %1, %2, %3":"=v"(r):"v"(a),"v"(b),"v"(c));return r;}
__device__ __forceinline__ float max2f(float a,float b){float r;asm("v_max_f32_e32 %0, %1, %2":"=v"(r):"v"(a),"v"(b));return r;}
__device__ __forceinline__ float fadd_s(float a,float b){float r;asm("v_add_f32_e32 %0, %1, %2":"=v"(r):"v"(a),"v"(b));return r;}
__device__ __forceinline__ float fsub_s(float a,float b){float r;asm("v_sub_f32_e32 %0, %1, %2":"=v"(r):"v"(a),"v"(b));return r;}
typedef float f32x2_t __attribute__((ext_vector_type(2))); typedef __bf16 bf16x2_t __attribute__((ext_vector_type(2)));
__device__ __forceinline__ unsigned cvtpk_s(float lo,float hi){f32x2_t v={lo,hi};bf16x2_t b=__builtin_convertvector(v,bf16x2_t);return __builtin_bit_cast(unsigned,b);}
#define WAIT_BAR(N) asm volatile("s_waitcnt vmcnt(" #N ") lgkmcnt(0)\n\ts_barrier":::"memory")
typedef LAS const char* lds_cptr;
typedef short v4i16_t __attribute__((ext_vector_type(4)));
__device__ __forceinline__ void qkt(f32x16&p0,f32x16&p1,lds_cptr Kslot,const bf16x8*qr,int r32,int hi){
  const lds_cptr kb=Kslot+hi*1024+r32*16;
  #pragma unroll
  for(int d0=0;d0<4;++d0){
    const bf16x8 b0=*(const LAS bf16x8*)(kb+d0*2048);
    const bf16x8 b1=*(const LAS bf16x8*)(kb+d0*2048+512);
    p0=__builtin_amdgcn_mfma_f32_32x32x16_bf16(b0,qr[d0],p0,0,0,0);p1=__builtin_amdgcn_mfma_f32_32x32x16_bf16(b1,qr[d0],p1,0,0,0);}
}
__device__ __forceinline__ void kload8(bf16x8*kf,lds_cptr kp){
  kf[0]=*(const LAS bf16x8*)(kp);      kf[1]=*(const LAS bf16x8*)(kp+512);
  kf[2]=*(const LAS bf16x8*)(kp+2048); kf[3]=*(const LAS bf16x8*)(kp+2560);
  kf[4]=*(const LAS bf16x8*)(kp+4096); kf[5]=*(const LAS bf16x8*)(kp+4608);
  kf[6]=*(const LAS bf16x8*)(kp+6144); kf[7]=*(const LAS bf16x8*)(kp+6656);
}
__device__ __forceinline__ void kload2(bf16x8*kf,lds_cptr kp,int j){ kf[2*j]=*(const LAS bf16x8*)(kp+j*2048); kf[2*j+1]=*(const LAS bf16x8*)(kp+j*2048+512); }
__device__ __forceinline__ s16x4 vtr(lds_cptr p){ return __builtin_bit_cast(s16x4,__builtin_amdgcn_ds_read_tr16_b64_v4i16((LAS v4i16_t*)p)); }
__device__ __forceinline__ float rowmax(const f32x16&p0,const f32x16&p1){
  float a=max3f(p0[0],p0[1],p1[0]),b=max3f(p0[2],p0[3],p1[1]);a=max3f(a,p1[2],p1[3]);
  #pragma unroll
  for(int r=4;r<16;r+=4){a=max3f(a,p0[r],p0[r+1]);b=max3f(b,p0[r+2],p0[r+3]);a=max3f(a,p1[r],p1[r+1]);b=max3f(b,p1[r+2],p1[r+3]);}
  const float m=max2f(a,b);
  auto rr=__builtin_amdgcn_permlane32_swap(__float_as_uint(m),__float_as_uint(m),false,false);
  return max2f(__uint_as_float(rr[0]),__uint_as_float(rr[1]));
}
__device__ __forceinline__ void pv(f32x16*o,int vb,bf16x8 pa0,bf16x8 pa1,bf16x8 pa2,bf16x8 pa3){
  #pragma unroll
  for(int d0=0;d0<2;++d0){s16x4 lo[4],hi[4];
    #pragma unroll
    for(int ks=0;ks<4;++ks){
      asm volatile("ds_read_b64_tr_b16 %0,%1 offset:%c2":"=&v"(lo[ks]):"v"(vb),"i"(d0*4096+ks*1024):"memory");
      asm volatile("ds_read_b64_tr_b16 %0,%1 offset:%c2":"=&v"(hi[ks]):"v"(vb),"i"(d0*4096+ks*1024+512):"memory");}
    asm volatile("s_waitcnt lgkmcnt(0)":::"memory");SBAR();
    #define PK(k) (bf16x8){lo[k][0],lo[k][1],lo[k][2],lo[k][3],hi[k][0],hi[k][1],hi[k][2],hi[k][3]}
    o[d0]=__builtin_amdgcn_mfma_f32_32x32x16_bf16(pa0,PK(0),o[d0],0,0,0);
    o[d0]=__builtin_amdgcn_mfma_f32_32x32x16_bf16(pa1,PK(1),o[d0],0,0,0);
    o[d0]=__builtin_amdgcn_mfma_f32_32x32x16_bf16(pa2,PK(2),o[d0],0,0,0);
    o[d0]=__builtin_amdgcn_mfma_f32_32x32x16_bf16(pa3,PK(3),o[d0],0,0,0);
    #undef PK
  }
}
template<int THRL,int EPI,int STAGE> __device__ __forceinline__ void fast_pass(const bf16_t*Qrows,const bf16_t*Kh,const bf16_t*Vh,const float*kbias,int qb,LAS char*shm,float f,int tid){
  constexpr int stage=STAGE;
  const int lane=tid&63,r32=lane&31,hi=lane>>5; const int wid=__builtin_amdgcn_readfirstlane(tid>>6);
  const int q0=qb*QB;
  const bf16_t*Qw=Qrows+(long)(wid*QBLK)*PITCH;
  const unsigned lds0=(unsigned)(uintptr_t)shm;
  LAS float*wsf=(LAS float*)(shm+LDS_WS)+wid*64;
  const LAS float*bias0=(const LAS float*)(shm+LDS_BIAS+wid*768);
  const unsigned koff=(unsigned)(lane*PITCH+wid*8)*2u;
  const unsigned voff=(unsigned)((16*(wid&3)+(lane>>2))*PITCH+(wid>>2)*32+(lane&3)*8)*2u;
  const unsigned boff=(unsigned)lane*4u;
  const unsigned kdst=lds0+LDS_K+wid*1024, vdst=lds0+LDS_V+wid*1024, bdst=lds0+LDS_BIAS+wid*768;
  #define DMA_K(t,slot) glds16(Kh+(long)(t)*KVBLK*PITCH,koff,(unsigned)__builtin_amdgcn_readfirstlane(kdst+(slot)))
  #define DMA_V(t,slot) glds16(Vh+(long)(t)*KVBLK*PITCH,voff,(unsigned)__builtin_amdgcn_readfirstlane(vdst+(slot)))
  #define DMA_B(t,slot) glds4(kbias+(t)*KVBLK,boff,(unsigned)__builtin_amdgcn_readfirstlane(bdst+((slot)>>5)))
  const int vb0=(int)(lds0+LDS_V)+((lane>>4)&1)*32+(lane&3)*8+(4*hi+((lane&15)>>2))*64;
  const lds_cptr shm3=(lds_cptr)shm; bf16x8 kf[8];
  const lds_cptr kp0=shm3+LDS_K+hi*1024+r32*16; const lds_cptr vp0=shm3+LDS_V+((lane>>4)&1)*32+(lane&3)*8+(4*hi+((lane&15)>>2))*64;
  const int NT=(q0+QB)/KVBLK;
  DMA_K(0,0);DMA_V(0,0);DMA_K(1,SLOTB);DMA_B(0,0);DMA_B(1,SLOTB);
  bf16x8 qr[4];
  #pragma unroll
  for(int d0=0;d0<4;++d0)qr[d0]=*reinterpret_cast<const bf16x8*>(&Qw[(long)r32*PITCH+d0*16+hi*8]);
  float mhat=0.f,l_reg=0.f;f32x16 o[2];o[0]=f32x16{};o[1]=f32x16{};
  const int qrel=wid*QBLK+r32;
  #define CMASK(P0,P1,t) do{int jb_=(t)-(NT-4); if(jb_>=0)cmask(P0,P1,jb_,qrel,hi);}while(0)
  #define NMB(nm0,nm1) do{ const LAS float* bs_=bias0+(sl_cur>>7); const float nmh_=-mhat; \
    _Pragma("unroll") for(int gq=0;gq<4;++gq){ const f32x4 c0_=*(const LAS f32x4*)(bs_+8*gq+4*hi), c1_=*(const LAS f32x4*)(bs_+32+8*gq+4*hi); \
      _Pragma("unroll") for(int j=0;j<4;++j){ nm0[4*gq+j]=nmh_-c0_[j]; nm1[4*gq+j]=nmh_-c1_[j]; } } }while(0)
  bool resc=false;
  #define START(P0,P1) do{ const float rm=rowmax(P0,P1); resc=false; \
    { const float dl=rm; mhat=fadd_s(mhat,dl); \
      _Pragma("unroll") for(int r=0;r<16;++r){P0[r]=fsub_s(P0[r],dl);P1[r]=fsub_s(P1[r],dl);} } \
    _Pragma("unroll") for(int r=0;r<16;++r)P0[r]=__builtin_amdgcn_exp2f(P0[r]); }while(0)
  #define RESC() do{ if(resc){ asm volatile("s_waitcnt lgkmcnt(0)":::"memory"); \
      _Pragma("unroll") for(int d_=0;d_<2;++d_) _Pragma("unroll") for(int r=0;r<16;++r)o[d_][r]*=wsf[crow(r,hi)]; } }while(0)
  f32x16 pA0,pA1,pB0,pB1;
  int sl_prev=0,sl_cur=0,sl_next=SLOTB;
  #define ROT() do{sl_prev=sl_cur;sl_cur=sl_next;sl_next=(sl_next==(NSLOT-1)*SLOTB)?0:sl_next+SLOTB;}while(0)
  DMA_K(2,2*SLOTB);
  WAIT_BAR(3);
  NMB(pA0,pA1);
  qkt(pA0,pA1,shm3+LDS_K,qr,r32,hi);asm volatile("s_nop 15\n\ts_nop 7":"+v"(pA0),"+v"(pA1));CMASK(pA0,pA1,0);
  START(pA0,pA1);
  _Pragma("unroll") for(int r=0;r<16;++r)pA1[r]=__builtin_amdgcn_exp2f(pA1[r]);
  WAIT_BAR(0);
  DMA_K(3,0);DMA_V(1,SLOTB);DMA_B(2,2*SLOTB);
  ROT();
  kload8(kf,kp0+sl_cur);
  WAIT_BAR(3);
  s16x4 vlo[8],vhi[8]; u32x4 pw0,pw1,pw2,pw3;
  #define PKW(P,B) cvtpk_s(P[B],P[B+1])
  #define PAF(k) __builtin_bit_cast(bf16x8,pw##k)
  #define VFR(i) (bf16x8){vlo[i][0],vlo[i][1],vlo[i][2],vlo[i][3],vhi[i][0],vhi[i][1],vhi[i][2],vhi[i][3]}
  #define PIN(x) asm volatile("":"+v"(x))
  #define MX3(a,b,c) __builtin_fmaxf(__builtin_fmaxf((a),(b)),(c))
  #define GAPA(MF,A0,A1,A2,A3,W0,W1,PW) do{ MF; sacc+=A0; sacc+=A1; sacc+=A2; sacc+=A3; PIN(sacc); W0; W1; PIN(PW); SBAR(); }while(0)
  #define EX(v) __builtin_amdgcn_exp2f(v)
  #define GAPB(MF,X,B) do{ MF; X[B]=EX(X[B]); X[B+1]=EX(X[B+1]); X[B+2]=EX(X[B+2]); X[B+3]=EX(X[B+3]); PIN(X); SBAR(); }while(0)
  #define VRD(i) do{ vlo[i]=vtr(vp_+(((i)>>2)*4096+((i)&3)*1024)); vhi[i]=vtr(vp_+(((i)>>2)*4096+((i)&3)*1024+512)); }while(0)
  #define KRD(G,j) do{ if(G){ kload2(kf,kp0+sl_next,j); SBAR(); } }while(0)
  #define STEP(C0,C1,P0,P1,t,GK,GV,GL,GB) do{ NMB(C0,C1); SBAR(); \
    const lds_cptr vp_=vp0+sl_prev; \
    VRD(0); SBAR(); float sacc=(P0[0]+P0[1]); \
    GAPA(C0=__builtin_amdgcn_mfma_f32_32x32x16_bf16(kf[0],qr[0],C0,0,0,0), P0[2],P0[3],P0[4],P0[5],     pw0[0]=PKW(P0,0), pw0[1]=PKW(P0,2), pw0); \
    VRD(4); SBAR(); GAPA(C1=__builtin_amdgcn_mfma_f32_32x32x16_bf16(kf[1],qr[0],C1,0,0,0), P0[6],P0[7],P0[8],P0[9],     pw0[2]=PKW(P0,4), pw0[3]=PKW(P0,6), pw0); \
    VRD(1); SBAR(); GAPA(C0=__builtin_amdgcn_mfma_f32_32x32x16_bf16(kf[2],qr[1],C0,0,0,0),   P0[10],P0[11],P0[12],P0[13], pw1[0]=PKW(P0,8), pw1[1]=PKW(P0,10), pw1); \
    VRD(5); SBAR(); GAPA(C1=__builtin_amdgcn_mfma_f32_32x32x16_bf16(kf[3],qr[1],C1,0,0,0),   P0[14],P0[15],P1[0],P1[1],   pw1[2]=PKW(P0,12),pw1[3]=PKW(P0,14), pw1); \
    VRD(2); SBAR(); GAPA(C0=__builtin_amdgcn_mfma_f32_32x32x16_bf16(kf[4],qr[2],C0,0,0,0),   P1[2],P1[3],P1[4],P1[5],     pw2[0]=PKW(P1,0), pw2[1]=PKW(P1,2), pw2); \
    VRD(6); SBAR(); GAPA(C1=__builtin_amdgcn_mfma_f32_32x32x16_bf16(kf[5],qr[2],C1,0,0,0),   P1[6],P1[7],P1[8],P1[9],     pw2[2]=PKW(P1,4), pw2[3]=PKW(P1,6), pw2); \
    VRD(3); SBAR(); GAPA(C0=__builtin_amdgcn_mfma_f32_32x32x16_bf16(kf[6],qr[3],C0,0,0,0),   P1[10],P1[11],P1[12],P1[13], pw3[0]=PKW(P1,8), pw3[1]=PKW(P1,10), pw3); \
    VRD(7); SBAR(); GAPA(C1=__builtin_amdgcn_mfma_f32_32x32x16_bf16(kf[7],qr[3],C1,0,0,0),   P1[14],P1[15],0.f,0.f,       pw3[2]=PKW(P1,12),pw3[3]=PKW(P1,14), pw3); \
    l_reg+=sacc; \
    if(GK){DMA_K((t)+3,sl_cur);} if(GV){DMA_V((t)+1,sl_next);} if(GB){DMA_B((t)+2,sl_prev);} \
    CMASK(C0,C1,t); \
    { float a=MX3(C0[0],C0[1],C1[0]),b=MX3(C0[2],C0[3],C1[1]); a=MX3(a,C1[2],C1[3]); \
      _Pragma("unroll") for(int r=4;r<16;r+=4){a=MX3(a,C0[r],C0[r+1]);b=MX3(b,C0[r+2],C0[r+3]);a=MX3(a,C1[r],C1[r+1]);b=MX3(b,C1[r+2],C1[r+3]);} \
      float rm=__builtin_fmaxf(a,b); { auto rr=__builtin_amdgcn_permlane32_swap(__float_as_uint(rm),__float_as_uint(rm),false,false); rm=__builtin_fmaxf(__uint_as_float(rr[0]),__uint_as_float(rr[1])); } \
      resc=false; \
      if(__builtin_expect(__any(rm>(float)THRL),0)){ const float dl=__builtin_fmaxf(rm,0.f); mhat+=dl; \
        _Pragma("unroll") for(int r=0;r<16;++r){C0[r]-=dl;C1[r]-=dl;} \
        const float f_=__builtin_amdgcn_exp2f(-dl); l_reg*=f_; if(hi==0)wsf[r32]=f_; resc=true; } } \
    SBAR(); \
    GAPB(o[0]=__builtin_amdgcn_mfma_f32_32x32x16_bf16(PAF(0),VFR(0),o[0],0,0,0), C0,0); \
    GAPB(o[1]=__builtin_amdgcn_mfma_f32_32x32x16_bf16(PAF(0),VFR(4),o[1],0,0,0), C0,4); \
    KRD(GL,0); GAPB(o[0]=__builtin_amdgcn_mfma_f32_32x32x16_bf16(PAF(1),VFR(1),o[0],0,0,0), C0,8); \
    KRD(GL,1); GAPB(o[1]=__builtin_amdgcn_mfma_f32_32x32x16_bf16(PAF(1),VFR(5),o[1],0,0,0), C0,12); \
    KRD(GL,2); GAPB(o[0]=__builtin_amdgcn_mfma_f32_32x32x16_bf16(PAF(2),VFR(2),o[0],0,0,0), C1,0); \
    KRD(GL,3); GAPB(o[1]=__builtin_amdgcn_mfma_f32_32x32x16_bf16(PAF(2),VFR(6),o[1],0,0,0), C1,4); \
    GAPB(o[0]=__builtin_amdgcn_mfma_f32_32x32x16_bf16(PAF(3),VFR(3),o[0],0,0,0), C1,8); \
    GAPB(o[1]=__builtin_amdgcn_mfma_f32_32x32x16_bf16(PAF(3),VFR(7),o[1],0,0,0), C1,12); \
    }while(0)
  int t=1;
  #undef CMASK
  #define CMASK(P0,P1,t) do{}while(0)
  for(;t+5<NT;t+=2){
    STEP(pB0,pB1,pA0,pA1,t,true,true,true,true);     WAIT_BAR(3); RESC(); ROT();
    STEP(pA0,pA1,pB0,pB1,t+1,true,true,true,true);   WAIT_BAR(3); RESC(); ROT();
  }
  #undef CMASK
  #define CMASK(P0,P1,t) do{int jb_=(t)-(NT-4); if(jb_>=0)cmask(P0,P1,jb_,qrel,hi);}while(0)
  #define ENDW(tt) do{ if((tt)+3<NT){WAIT_BAR(3);} else if((tt)+2<NT){WAIT_BAR(2);} else {WAIT_BAR(0);} }while(0)
  for(;t+1<NT;t+=2){
    STEP(pB0,pB1,pA0,pA1,t,(t+3<NT),(t+1<NT),(t+1<NT),(t+2<NT));       ENDW(t);   RESC(); ROT();
    STEP(pA0,pA1,pB0,pB1,t+1,(t+4<NT),(t+2<NT),(t+2<NT),(t+3<NT));     ENDW(t+1); RESC(); ROT();
  }
  STEP(pB0,pB1,pA0,pA1,NT-1,false,false,false,false); RESC();
  { float sacc=pB0[0]+pB0[1]; _Pragma("unroll") for(int r=2;r<16;++r)sacc+=pB0[r]; _Pragma("unroll") for(int r=0;r<16;++r)sacc+=pB1[r]; l_reg+=sacc;
    pw0=(u32x4){PKW(pB0,0),PKW(pB0,2),PKW(pB0,4),PKW(pB0,6)};pw1=(u32x4){PKW(pB0,8),PKW(pB0,10),PKW(pB0,12),PKW(pB0,14)};pw2=(u32x4){PKW(pB1,0),PKW(pB1,2),PKW(pB1,4),PKW(pB1,6)};pw3=(u32x4){PKW(pB1,8),PKW(pB1,10),PKW(pB1,12),PKW(pB1,14)};
    SBAR(); pv(o,vb0+sl_cur,PAF(0),PAF(1),PAF(2),PAF(3)); }
  #undef PKW
  #undef PAF
  #undef VFR
  #undef PIN
  #undef MX3
  #undef GAPA
  #undef GAPB
  #undef EX
  #undef VRD
  #undef KRD
  #undef STEP
  #undef ENDW
  #undef NMB
  {auto rr=__builtin_amdgcn_permlane32_swap(__float_as_uint(l_reg),__float_as_uint(l_reg),false,false);l_reg=__uint_as_float(rr[0])+__uint_as_float(rr[1]);}
  if(hi==0)wsf[32+r32]=l_reg;asm volatile("s_waitcnt lgkmcnt(0)":::"memory");
  float rli[16];
  #pragma unroll
  for(int r=0;r<16;++r)rli[r]=__builtin_amdgcn_rcpf(wsf[32+crow(r,hi)]);
  { LAS bf16_t*stg=(LAS bf16_t*)(shm+LDS_OST+(stage*NW+wid)*4096);
    #pragma unroll
    for(int r=0;r<16;++r){const int orow=crow(r,hi);
      #pragma unroll
      for(int d0=0;d0<2;++d0){ const int idx=orow*64+d0*32+r32; float val=o[d0][r]*rli[r];
        if(EPI==1) val=__uint_as_float(((unsigned)stg[idx])<<16)-f*val;
        stg[idx]=(bf16_t)(cvtpk_s(val,0.f)&0xffffu); } } }
  asm volatile("s_waitcnt lgkmcnt(0)\n\ts_barrier":::"memory");
  #undef DMA_K
  #undef DMA_V
  #undef DMA_B
  #undef CMASK
  #undef START
  #undef RESC
  #undef ROT
}
#undef SBAR
#undef WAIT_BAR

__device__ __forceinline__ void fox_final(LAS char*shm,bf16_t*Qrows,int tid){
  const int lane=tid&63; const int wid=__builtin_amdgcn_readfirstlane(tid>>6);
  const LAS bf16_t*stg=(const LAS bf16_t*)(shm+LDS_OST+wid*4096); bf16_t*Ow=Qrows+(size_t)(wid*QBLK)*PITCH;
  #pragma unroll
  for(int i=0;i<4;++i){const int row=i*8+(lane>>3),ch=lane&7; const u32x4 v=*(const LAS u32x4*)(stg+row*64+ch*8); *(u32x4*)(Ow+(size_t)row*PITCH+ch*8)=v;}
}
__device__ __forceinline__ void diff_final(LAS char*shm,bf16_t*Qrows,float post,const float*gn,int tid){
  const int lane=tid&63; const int wid=__builtin_amdgcn_readfirstlane(tid>>6);
  const int row=lane>>1,hv=lane&1;
  const LAS bf16_t*stg=(const LAS bf16_t*)(shm+LDS_OST+(hv*NW+wid)*4096)+row*64;
  float v[64]; float ss=0.f;
  #pragma unroll
  for(int c=0;c<8;++c){ const u32x4 w=*(const LAS u32x4*)(stg+c*8);
    #pragma unroll
    for(int j=0;j<4;++j){ v[8*c+2*j]=__uint_as_float(w[j]<<16); v[8*c+2*j+1]=__uint_as_float(w[j]&0xffff0000u); ss+=v[8*c+2*j]*v[8*c+2*j]+v[8*c+2*j+1]*v[8*c+2*j+1]; } }
  ss+=__shfl_xor(ss,1);
  const float rr=post/sqrtf(ss*(1.f/128.f)+RMS_EPS);
  bf16_t*orow=Qrows+(size_t)(wid*QBLK+row)*PITCH+hv*64; const float*g=gn+hv*64;
  #pragma unroll
  for(int c=0;c<8;++c){ const f32x4 g0=*(const f32x4*)(g+8*c), g1=*(const f32x4*)(g+8*c+4); u32x4 w;
    w[0]=cvtpk_s(v[8*c]*rr*g0[0],v[8*c+1]*rr*g0[1]); w[1]=cvtpk_s(v[8*c+2]*rr*g0[2],v[8*c+3]*rr*g0[3]); w[2]=cvtpk_s(v[8*c+4]*rr*g1[0],v[8*c+5]*rr*g1[1]); w[3]=cvtpk_s(v[8*c+6]*rr*g1[2],v[8*c+7]*rr*g1[3]);
    *(u32x4*)(orow+8*c)=w; }
}
#undef LAS
}

#define LAS __attribute__((address_space(3)))
typedef unsigned short bf16;
typedef unsigned v4u __attribute__((ext_vector_type(4)));
typedef float f32x4 __attribute__((ext_vector_type(4)));
constexpr int NWAVES = 8;
constexpr int RING_BYTES = 131072;
constexpr int LDSCTL_OFF = RING_BYTES;
constexpr int LDS_BYTES = 139264;
static_assert(att::ATT_LDS_BYTES <= RING_BYTES && af::LDS_BYTES <= RING_BYTES && att::L_B + 512 <= af::LDS_MISC, "attention scratch fits the ring region");

__device__ __forceinline__ unsigned f2bf(float f) { unsigned u = __builtin_bit_cast(unsigned, f); return (u + 0x7fffu + ((u >> 16) & 1u)) >> 16; }
__device__ __forceinline__ unsigned pk2(float lo, float hi) { return f2bf(lo) | (f2bf(hi) << 16); }
__device__ __forceinline__ float wave_sum(float v) {
#pragma unroll
    for (int o = 1; o < 64; o <<= 1) v += __shfl_xor(v, o);
    return v;
}
__device__ __forceinline__ void transpose_item(const float* W, int ldw, int K, bf16* WT, LAS float* scr, int kb, int lane) {
    const int k0 = 64 * kb;
    float t[32];
#pragma unroll
    for (int i = 0; i < 32; ++i) { const int kk = 2 * i + (lane >> 5); t[i] = W[(size_t)(k0 + kk) * ldw + (lane & 31)]; }
    asm volatile("" ::: "memory");
#pragma unroll
    for (int i = 0; i < 32; ++i) { const int kk = 2 * i + (lane >> 5); scr[kk * 33 + (lane & 31)] = t[i]; }
    asm volatile("s_waitcnt lgkmcnt(0)" ::: "memory");
    const int c = lane & 7;
#pragma unroll
    for (int j = 0; j < 4; ++j) { const int n = (lane >> 3) + 8 * j; const LAS float* s = scr + (8 * c) * 33 + n;
        v4u o; o.x = pk2(s[0 * 33], s[1 * 33]); o.y = pk2(s[2 * 33], s[3 * 33]); o.z = pk2(s[4 * 33], s[5 * 33]); o.w = pk2(s[6 * 33], s[7 * 33]);
        *(v4u*)(WT + (size_t)n * K + k0 + 8 * c) = o; }
    asm volatile("s_waitcnt lgkmcnt(0)" ::: "memory");
}
__device__ __forceinline__ int src_col_qkv(int n) { const int s = n >> 9; const int c = s == 0 ? 0 : s == 1 ? 2048 : s == 2 ? 4104 : s == 3 ? 512 : s == 4 ? 1024 : s == 5 ? 2560 : s == 6 ? 3072 : s == 7 ? 4616 : 5128; return c + (n & 511); }
__device__ __forceinline__ int src_col_zg(int n) { if (n >= 1536) return 6152 + (n - 1536); const int s = n >> 9; return (s == 0 ? 1536 : s == 1 ? 3592 : 5640) + (n & 511); }

#define XB_TMO      128
#define XB_XCNT(j)  (256  + 64 * (j))
#define XB_XSUB(j)  (1280 + 64 * (j))
#define XB_XGEN(j)  (2304 + 64 * (j))
#define XB_TOP      3328
#define XB_TOPGEN   3392
#define XCD_BAR_WORDS 3456
#define XB_SPIN_CAP (1u << 24)

__device__ __forceinline__ unsigned xb_ld(unsigned* p)              { return __hip_atomic_load(p, __ATOMIC_RELAXED, __HIP_MEMORY_SCOPE_AGENT); }
__device__ __forceinline__ unsigned xb_add(unsigned* p, unsigned v) { return __hip_atomic_fetch_add(p, v, __ATOMIC_RELAXED, __HIP_MEMORY_SCOPE_AGENT); }
__device__ __forceinline__ unsigned xb_xcc_id() { return (unsigned)__builtin_amdgcn_s_getreg((3 << 11) | 20) & 0xFu; }
#define XB_SPIN(cond, bar) do { unsigned _sp = 0; while (cond) { __builtin_amdgcn_s_sleep(1); \
    if ((++_sp & 255u) == 0u) { if (xb_ld(&(bar)[XB_TMO])) break; if (_sp > XB_SPIN_CAP) { atomicAdd(&(bar)[XB_TMO], 1u); break; } } } } while (0)

struct XcdBarrier {
    unsigned* bar; unsigned x;
    volatile LAS unsigned* st;
};

__device__ __forceinline__ XcdBarrier xcd_barrier_post(unsigned* bar, volatile LAS unsigned* st) {
    XcdBarrier b; b.bar = bar; b.x = xb_xcc_id(); b.st = st;
    if (threadIdx.x == 0) (void)xb_add(&bar[XB_XCNT(b.x)], 1u);
    return b;
}
__device__ __forceinline__ void xcd_barrier_complete(unsigned* bar, unsigned x, unsigned& nloc, unsigned& nx) {
    const unsigned G = gridDim.x * gridDim.y * gridDim.z;
    unsigned sum, cnt, mine, sp = 0u;
    for (;;) {
        sum = 0u; cnt = 0u; mine = 0u;
#pragma unroll
        for (unsigned j = 0; j < 16; ++j) { const unsigned c = xb_ld(&bar[XB_XCNT(j)]); sum += c; cnt += (c > 0u) ? 1u : 0u; mine = (j == x) ? c : mine; }
        if (sum == G) break;
        __builtin_amdgcn_s_sleep(1);
        if ((++sp & 255u) == 0u) { if (xb_ld(&bar[XB_TMO])) break; if (sp > XB_SPIN_CAP) { atomicAdd(&bar[XB_TMO], 1u); break; } }
    }
    nloc = mine > 0u ? mine : 1u; nx = cnt > 0u ? cnt : 1u;
}

__device__ __forceinline__ void xcd_barrier(const XcdBarrier& b) {
    asm volatile("s_waitcnt vmcnt(0)" ::: "memory");
    __syncthreads();
    if (threadIdx.x == 0) {
        unsigned* bar = b.bar;
        __builtin_amdgcn_s_waitcnt(0);
        unsigned nloc = b.st[0], nx = b.st[1];
        if (nloc == 0u) { xcd_barrier_complete(bar, b.x, nloc, nx); b.st[0] = nloc; b.st[1] = nx; }
        const unsigned old = xb_add(&bar[XB_XSUB(b.x)], 1u);
        const unsigned gen = old / nloc;
        if (old + 1u == (gen + 1u) * nloc) {
            __builtin_amdgcn_fence(__ATOMIC_RELEASE, "agent");
            asm volatile("s_waitcnt vmcnt(0)" ::: "memory");
            const unsigned og = xb_add(&bar[XB_TOP], 1u);
            const unsigned tg = og / nx;
            if (og + 1u == (tg + 1u) * nx) xb_add(&bar[XB_TOPGEN], 1u);
            else XB_SPIN(xb_ld(&bar[XB_TOPGEN]) == tg, bar);
            __builtin_amdgcn_fence(__ATOMIC_ACQUIRE, "agent");
            xb_add(&bar[XB_XGEN(b.x)], 1u);
            asm volatile("s_waitcnt vmcnt(0)" ::: "memory");
        } else {
            XB_SPIN(xb_ld(&bar[XB_XGEN(b.x)]) == gen, bar);
            __builtin_amdgcn_fence(__ATOMIC_ACQUIRE, "agent");
            asm volatile("s_waitcnt vmcnt(0)" ::: "memory");
        }
    }
    __syncthreads();
}

struct Args { const float* in[9]; float* out; unsigned char* ws; };
__device__ __forceinline__ void load_args(Args& A) {
    const __attribute__((address_space(4))) Args* ap_ = (const __attribute__((address_space(4))) Args*)__builtin_amdgcn_kernarg_segment_ptr(); asm volatile("" : "+s"(ap_));
#pragma unroll
    for (int i = 0; i < 9; ++i) A.in[i] = ap_->in[i];
    A.out = ap_->out; A.ws = ap_->ws;
}
#define ARGS_FRESH(A) Args A; load_args(A)

__device__ __forceinline__ void phase_weights(LAS unsigned char* lds) {
    int tid = threadIdx.x; asm volatile("" : "+v"(tid)); const int lane = tid & 63, wave = __builtin_amdgcn_readfirstlane(tid >> 6); (void)lane; (void)wave;
    ARGS_FRESH(A);
    LAS float* scr = (LAS float*)(lds + wave * 16384);
    const int gw = blockIdx.x * NWAVES + wave, NGW = gridDim.x * NWAVES;
    for (int i = gw * 64 + lane; i < 4 * SEQ; i += NGW * 64) ((float*)(A.ws + WS_ALIBI))[i] = -__builtin_amdgcn_exp2f(-2.f * (float)((i >> 12) + 1)) * LOG2E * (float)(i & (SEQ - 1));
    constexpr int I_IN = 16 * 144, I_B = 3 * 8 * 32, I_O = 16 * 32, I_LAYER = 2 * I_IN + I_B + I_O;
    for (int it = gw; it < NLAYER * I_LAYER; it += NGW) {
        const int l = it / I_LAYER; int r = it % I_LAYER;
        bf16* wl = (bf16*)(A.ws + WS_W + (size_t)l * W_LAYER);
        const float* w_in = A.in[2] + (size_t)l * DM * INW;
        if (r < I_IN) { const int kb = r / 144, n0 = (r % 144) * 32; transpose_item(w_in + src_col_qkv(n0), INW, 1024, (bf16*)((unsigned char*)wl + W_QKV) + (size_t)n0 * 1024, scr, kb, lane); continue; } r -= I_IN;
        if (r < I_IN) { const int kb = r / 144, n0 = (r % 144) * 32; transpose_item(w_in + src_col_zg(n0), INW, 1024, (bf16*)((unsigned char*)wl + W_ZG) + (size_t)n0 * 1024, scr, kb, lane); continue; } r -= I_IN;
        if (r < I_B) { const int nb = r / 256, rr = r % 256, kb = rr / 32, n0 = (rr % 32) * 32;
            transpose_item(A.in[6] + ((size_t)(l * 3 + nb) * 512) * 1024 + n0, 1024, 512, (bf16*)((unsigned char*)wl + W_B) + ((size_t)nb * 1024 + n0) * 512, scr, kb, lane); continue; } r -= I_B;
        { const int kb = r / 32, n0 = (r % 32) * 32; transpose_item(A.in[7] + (size_t)l * 1024 * 1024 + n0, 1024, 1024, (bf16*)((unsigned char*)wl + W_O) + (size_t)n0 * 1024, scr, kb, lane); }
    }
}

__device__ __forceinline__ void phase_norm(int l, bool first, LAS unsigned char* lds) {
    int tid = threadIdx.x; asm volatile("" : "+v"(tid)); const int lane = tid & 63, wave = __builtin_amdgcn_readfirstlane(tid >> 6); (void)lane; (void)wave;
    ARGS_FRESH(A); asm volatile("" : "+s"(l)); const float* xin = first ? A.in[0] : A.out;
    LAS float* wf = (LAS float*)lds;
    const float* w_in = A.in[2] + (size_t)l * DM * INW;
    for (int idx = tid; idx < 8192; idx += NWAVES * 64) { const int k = idx >> 3, h = idx & 7; wf[h * 1024 + k] = w_in[(size_t)k * INW + 3584 + h]; }
    __syncthreads();
    if (blockIdx.x == 0 && wave == 0) {
        const float* dl = A.in[4] + (size_t)l * 256;
        const float sa = wave_sum(dl[lane] * dl[64 + lane]), sb = wave_sum(dl[128 + lane] * dl[192 + lane]);
        const float lam_init = 0.8f - 0.6f * expf(-0.3f * (float)l);
        if (lane == 0) ((float*)(A.ws + WS_CTL))[CW_LAM + l] = expf(sa) - expf(sb) + lam_init;
    }
    const float* g = A.in[1] + (size_t)l * DM; const float* fb = A.in[3] + l * 8;
    bf16* XN = (bf16*)(A.ws + WS_XN); float* LOGF = (float*)(A.ws + WS_LOGF);
    f32x4 gv[4];
#pragma unroll
    for (int j = 0; j < 4; ++j) gv[j] = *(const f32x4*)(g + 4 * lane + 256 * j);
    f32x4 wr[8][4];
#pragma unroll
    for (int h = 0; h < 8; ++h)
#pragma unroll
        for (int j = 0; j < 4; ++j) wr[h][j] = *(const LAS f32x4*)(wf + h * 1024 + 4 * lane + 256 * j);
    const bool b0 = lane & 1, b1 = lane & 2, b2 = lane & 4;
    const int head = 4 * (lane & 1) + (lane & 2) + ((lane >> 2) & 1);
    const float fbv = fb[head];
    const int gw = blockIdx.x * NWAVES + wave, NGW = gridDim.x * NWAVES;
    auto load_row = [&](f32x4 (&d)[4], int m) { const f32x4* xr = (const f32x4*)(xin + (size_t)m * DM) + lane;
#pragma unroll
        for (int j = 0; j < 4; ++j) d[j] = xr[64 * j]; };
    auto do_row = [&](f32x4 (&v)[4], const int m) {
        float ss = 0.f;
#pragma unroll
        for (int j = 0; j < 4; ++j) ss += (v[j].x * v[j].x + v[j].y * v[j].y) + (v[j].z * v[j].z + v[j].w * v[j].w);
        const float rs = 1.f / sqrtf(wave_sum(ss) * (1.f / DM) + RMS_EPS);
        unsigned long long* o8 = (unsigned long long*)(XN + (size_t)m * DM) + lane;
        float f[8] = {0.f, 0.f, 0.f, 0.f, 0.f, 0.f, 0.f, 0.f};
#pragma unroll
        for (int j = 0; j < 4; ++j) { v[j] = v[j] * rs * gv[j];
            o8[64 * j] = (unsigned long long)pg8::cvt_pk_bf16(v[j].x, v[j].y) | ((unsigned long long)pg8::cvt_pk_bf16(v[j].z, v[j].w) << 32);
#pragma unroll
            for (int h = 0; h < 8; ++h) { const f32x4 w4 = wr[h][j]; f[h] = fmaf(v[j].x, w4.x, f[h]); f[h] = fmaf(v[j].y, w4.y, f[h]); f[h] = fmaf(v[j].z, w4.z, f[h]); f[h] = fmaf(v[j].w, w4.w, f[h]); } }
        float g4[4], g2[2];
#pragma unroll
        for (int i = 0; i < 4; ++i) { const float keep = b0 ? f[4 + i] : f[i], send = b0 ? f[i] : f[4 + i]; g4[i] = keep + __shfl_xor(send, 1); }
#pragma unroll
        for (int i = 0; i < 2; ++i) { const float keep = b1 ? g4[2 + i] : g4[i], send = b1 ? g4[i] : g4[2 + i]; g2[i] = keep + __shfl_xor(send, 2); }
        float fs; { const float keep = b2 ? g2[1] : g2[0], send = b2 ? g2[0] : g2[1]; fs = keep + __shfl_xor(send, 4); }
        fs += __shfl_xor(fs, 8); fs += __shfl_xor(fs, 16); fs += __shfl_xor(fs, 32);
        if (lane < 8) { const float xv = fs + fbv;
            const float ls2 = fminf(xv, 0.f) * LOG2E - __builtin_amdgcn_logf(1.f + __builtin_amdgcn_exp2f(-fabsf(xv) * LOG2E));
            LOGF[((size_t)(m / SEQ) * 8 + head) * SEQ + (m % SEQ)] = ls2; } };
    f32x4 va[4], vb[4];
    if (gw < MTOK) load_row(va, gw);
    if (gw + NGW < MTOK) load_row(vb, gw + NGW);
    for (int m = gw; m < MTOK; m += 2 * NGW) {
        { f32x4 v[4];
#pragma unroll
          for (int j = 0; j < 4; ++j) v[j] = va[j];
          if (m + 2 * NGW < MTOK) load_row(va, m + 2 * NGW);
          asm volatile("" ::: "memory");
          do_row(v, m); }
        if (m + NGW >= MTOK) break;
        { f32x4 v[4];
#pragma unroll
          for (int j = 0; j < 4; ++j) v[j] = vb[j];
          if (m + 3 * NGW < MTOK) load_row(vb, m + 3 * NGW);
          asm volatile("" ::: "memory");
          do_row(v, m + NGW); }
    }
    __syncthreads();
}
__device__ __forceinline__ void phase_cumsum(LAS unsigned char* lds) {
    int tid = threadIdx.x; asm volatile("" : "+v"(tid)); const int lane = tid & 63, wave = __builtin_amdgcn_readfirstlane(tid >> 6);
    if (blockIdx.x >= 64) return;
    ARGS_FRESH(A);
    const int bh = blockIdx.x;
    volatile LAS float* wt = (volatile LAS float*)(lds + LDSCTL_OFF + 64);
    const float* src = (const float*)(A.ws + WS_LOGF) + (size_t)bh * SEQ + 512 * wave + 8 * lane; float* dst = (float*)(A.ws + WS_CL2) + (size_t)bh * SEQ + 512 * wave + 8 * lane;
    f32x4 v0 = ((const f32x4*)src)[0], v1 = ((const f32x4*)src)[1];
    v0.y += v0.x; v0.z += v0.y; v0.w += v0.z; v1.x += v0.w; v1.y += v1.x; v1.z += v1.y; v1.w += v1.z;
    const float tot = v1.w; float inc = tot;
#pragma unroll
    for (int o = 1; o < 64; o <<= 1) { const float t = __shfl_up(inc, o); if (lane >= o) inc += t; }
    if (lane == 63) wt[wave] = inc;
    __syncthreads();
    float run = inc - tot;
#pragma unroll
    for (int w = 0; w < NWAVES - 1; ++w) run += (w < wave) ? wt[w] : 0.f;
    v0 = v0 + run; v1 = v1 + run;
    ((f32x4*)dst)[0] = v0; ((f32x4*)dst)[1] = v1;
}
__device__ __forceinline__ void phase_final() {
    int tid = threadIdx.x; asm volatile("" : "+v"(tid)); const int lane = tid & 63, wave = __builtin_amdgcn_readfirstlane(tid >> 6); (void)lane; (void)wave;
    ARGS_FRESH(A);
    const float* g = A.in[8]; float* X = A.out;
    f32x4 gv[4];
#pragma unroll
    for (int j = 0; j < 4; ++j) gv[j] = *(const f32x4*)(g + 4 * lane + 256 * j);
    const int gw = blockIdx.x * NWAVES + wave, NGW = gridDim.x * NWAVES;
    auto load_row = [&](f32x4 (&d)[4], int m) { const f32x4* xr = (const f32x4*)(X + (size_t)m * DM) + lane;
#pragma unroll
        for (int j = 0; j < 4; ++j) d[j] = xr[64 * j]; };
    auto do_row = [&](const f32x4 (&v)[4], const int m) {
        f32x4* xr = (f32x4*)(X + (size_t)m * DM) + lane; float ss = 0.f;
#pragma unroll
        for (int j = 0; j < 4; ++j) ss += (v[j].x * v[j].x + v[j].y * v[j].y) + (v[j].z * v[j].z + v[j].w * v[j].w);
        const float rs = 1.f / sqrtf(wave_sum(ss) * (1.f / DM) + RMS_EPS);
#pragma unroll
        for (int j = 0; j < 4; ++j) xr[64 * j] = v[j] * rs * gv[j]; };
    f32x4 va[4], vb[4];
    if (gw < MTOK) load_row(va, gw);
    if (gw + NGW < MTOK) load_row(vb, gw + NGW);
    for (int m = gw; m < MTOK; m += 2 * NGW) {
        { f32x4 v[4];
#pragma unroll
          for (int j = 0; j < 4; ++j) v[j] = va[j];
          if (m + 2 * NGW < MTOK) load_row(va, m + 2 * NGW);
          asm volatile("" ::: "memory");
          do_row(v, m); }
        if (m + NGW >= MTOK) break;
        { f32x4 v[4];
#pragma unroll
          for (int j = 0; j < 4; ++j) v[j] = vb[j];
          if (m + 3 * NGW < MTOK) load_row(vb, m + 3 * NGW);
          asm volatile("" ::: "memory");
          do_row(v, m + NGW); }
    }
}
__device__ __forceinline__ void phase_attention(int l, LAS unsigned char* lds) {
    int tid = threadIdx.x; asm volatile("" : "+v"(tid)); const int lane = tid & 63, wave = __builtin_amdgcn_readfirstlane(tid >> 6); (void)lane; (void)wave;
    ARGS_FRESH(A); asm volatile("" : "+s"(l));
    unsigned* qhead = (unsigned*)(A.ws + WS_CTL) + CW_QUEUE + 64 * l;
    volatile LAS unsigned* misc = (volatile LAS unsigned*)(lds + LDSCTL_OFF + 128);
    bf16* QKV = (bf16*)(A.ws + WS_QKV); const size_t BUF = (size_t)MTOK * 512;
    const float lam = ((const float*)(A.ws + WS_CTL))[CW_LAM + l];
    const float post = 1.f - (0.8f - 0.6f * expf(-0.3f * (float)l));
    unsigned nxt = 0u; if (tid == 0) nxt = atomicAdd(qhead, 1u);
    for (;;) {
        if (tid == 0) misc[0] = nxt;
        __syncthreads();
        const int idx = (int)misc[0];
        __syncthreads();
        if (idx >= att::N_ATT_UNITS) break;
        if (tid == 0) nxt = atomicAdd(qhead, 1u);
        if (idx < att::N_DIFF_UNITS) {
            const int qb = 15 - idx / 32, bh = idx % 32, b = bh >> 2, h = bh & 3;
            att::diff_unit((LAS char*)lds, b, h, qb, QKV + 0 * BUF, QKV + 3 * BUF, QKV + 4 * BUF, lam, post, A.in[5] + (size_t)l * 512 + h * 128);
        } else if (idx < att::N_DIFF_UNITS + att::N_FOX_UNITS) {
            int tid2 = threadIdx.x; asm volatile("" : "+v"(tid2));
            const int j = idx - att::N_DIFF_UNITS, qb = 15 - j / 64, bh = j % 64, b = bh >> 3, h = bh & 7; const size_t t0 = (size_t)b * SEQ;
            bf16* Qr = QKV + 1 * BUF + (t0 + qb * 256) * 512 + h * 64;
            af::fast_pass<64, 0, 0>(Qr, QKV + 5 * BUF + t0 * 512 + h * 64, QKV + 6 * BUF + t0 * 512 + h * 64, (const float*)(A.ws + WS_CL2) + (size_t)bh * SEQ, qb, (LAS char*)lds, 0.f, tid2);
            af::fox_final((LAS char*)lds, Qr, tid2);
        } else {
            const int j = idx - att::N_DIFF_UNITS - att::N_FOX_UNITS, p = j >> 10, jj = j & 1023, bhp = jj >> 5, sub = jj & 31, b = bhp >> 2, hp = bhp & 3;
            const int nblk = 32 >> (2 * p), r = sub / nblk, blk = sub % nblk;
            att::dil_unit((LAS char*)lds, p, b, hp, r, blk, QKV + 2 * BUF, QKV + 7 * BUF, QKV + 8 * BUF, (bf16*)(A.ws + WS_DILO), (float*)(A.ws + WS_LSE));
        }
    }
}

#define GRID_SYNC() do { ARGS_FRESH(Ab); XcdBarrier bar_; bar_.bar = (unsigned*)(Ab.ws + WS_CTL) + CW_BAR; bar_.x = xb_xcc_id(); bar_.st = (volatile LAS unsigned*)(lds + LDSCTL_OFF) + 8; xcd_barrier(bar_); } while (0)
#define FRESH() ARGS_FRESH(A); unsigned char* ws = A.ws; int l = lyr; asm volatile("" : "+s"(l))
__device__ __forceinline__ void layer_phases(const int lyr, LAS unsigned char* lds, const int G, const int bx) {
        phase_cumsum(lds);
        { FRESH(); pg8::Gemm g{(const bf16*)(ws + WS_XN), (const bf16*)(ws + WS_W + (size_t)l * W_LAYER + W_QKV), MTOK, 4608, 1024}; pg8::StaticOrder S; S.init(MTOK, 4608, G, bx);
          pg8::EpiQKV E{(bf16*)(ws + WS_QKV)};

          pg8::gemm_phase<pg8::EpiQKV, pg8::StaticOrder, true, true>(lds, g, S, E);
          }
        GRID_SYNC();
        phase_attention(lyr, lds);
        GRID_SYNC();
        { FRESH(); pg8::Gemm g{(const bf16*)(ws + WS_XN), (const bf16*)(ws + WS_W + (size_t)l * W_LAYER + W_ZG), MTOK, 4608, 1024}; pg8::StaticOrder S; S.init(MTOK, 4608, G, bx);
          pg8::EpiZG E{(bf16*)(ws + WS_QKV), (bf16*)(ws + WS_GATES), (const bf16*)(ws + WS_DILO), (const float*)(ws + WS_LSE)};

          pg8::gemm_phase<pg8::EpiZG, pg8::StaticOrder, true, true>(lds, g, S, E);
          }
        GRID_SYNC();
        { FRESH(); pg8::StaticOrder S; S.init(MTOK, 1024, G, bx);
          pg8::Gemm g{(const bf16*)(ws + WS_QKV), (const bf16*)(ws + WS_W + (size_t)l * W_LAYER + W_B), MTOK, 1024, 512}; pg8::EpiBranch<0> E{(const bf16*)(ws + WS_GATES), (bf16*)(ws + WS_XN)};

          pg8::gemm_phase<pg8::EpiBranch<0>, pg8::StaticOrder, false, true>(lds, g, S, E);
          }
        { FRESH(); pg8::StaticOrder S; S.init(MTOK, 1024, G, bx);
          pg8::Gemm g{(const bf16*)(ws + WS_QKV + QKV_BUF), (const bf16*)(ws + WS_W + (size_t)l * W_LAYER + W_B + (size_t)1 * 1024 * 512 * 2), MTOK, 1024, 512}; pg8::EpiBranch<1> E{(const bf16*)(ws + WS_GATES), (bf16*)(ws + WS_XN)};

          pg8::gemm_phase<pg8::EpiBranch<1>, pg8::StaticOrder, false, true>(lds, g, S, E);
          }
        { FRESH(); pg8::StaticOrder S; S.init(MTOK, 1024, G, bx);
          pg8::Gemm g{(const bf16*)(ws + WS_QKV + 2 * QKV_BUF), (const bf16*)(ws + WS_W + (size_t)l * W_LAYER + W_B + (size_t)2 * 1024 * 512 * 2), MTOK, 1024, 512}; pg8::EpiBranch<2> E{(const bf16*)(ws + WS_GATES), (bf16*)(ws + WS_XN)};

          pg8::gemm_phase<pg8::EpiBranch<2>, pg8::StaticOrder, false, true>(lds, g, S, E);
          }
        GRID_SYNC();
        { FRESH(); pg8::Gemm g{(const bf16*)(ws + WS_XN), (const bf16*)(ws + WS_W + (size_t)l * W_LAYER + W_O), MTOK, 1024, 1024}; pg8::StaticOrder S; S.init(MTOK, 1024, G, bx);
          pg8::EpiOut E{l == 0 ? A.in[0] : A.out, A.out};

          pg8::gemm_phase<pg8::EpiOut, pg8::StaticOrder, false, true>(lds, g, S, E);
          }
        GRID_SYNC();
        if (lyr + 1 < NLAYER) { phase_norm(lyr + 1, false, lds); GRID_SYNC(); }
    }

__global__ void __launch_bounds__(NWAVES * 64, 2) fwd_megakernel(Args Akarg) {
    extern __shared__ __attribute__((aligned(16))) unsigned char lds_raw[];
    LAS unsigned char* lds = (LAS unsigned char*)lds_raw;
    const int G = gridDim.x, bx = blockIdx.x;
    if (threadIdx.x < 64) ((LAS unsigned*)(lds + LDSCTL_OFF))[threadIdx.x] = 0u;
    __syncthreads();
    { ARGS_FRESH(A); (void)xcd_barrier_post((unsigned*)(A.ws + WS_CTL) + CW_BAR, (volatile LAS unsigned*)(lds + LDSCTL_OFF) + 8); }
    phase_weights(lds);
    __syncthreads();
    phase_norm(0, true, lds);
    GRID_SYNC();
    layer_phases(0, lds, G, bx);
    layer_phases(1, lds, G, bx);
    phase_final();
}

extern "C" void kernel_launch(void* const* d_in, const int* in_sizes, int n_in, void* d_out, int out_size, void* d_ws, size_t ws_size, hipStream_t stream) {
    static int grid = 0;
    if (grid == 0) {
        if (n_in != 9 || in_sizes[0] != MTOK * DM || out_size != MTOK * DM || ws_size < WS_END) { fprintf(stderr, "kernel_launch: unexpected shapes (n_in %d, in0 %d, out %d, ws %zu); nothing launched\n", n_in, n_in > 0 ? in_sizes[0] : -1, out_size, ws_size); grid = -1; return; }
        int dev = 0, cus = 0, per_cu = 0;
        if (hipGetDevice(&dev) != hipSuccess || hipDeviceGetAttribute(&cus, hipDeviceAttributeMultiprocessorCount, dev) != hipSuccess) { grid = -1; return; }
        if (hipFuncSetAttribute((const void*)fwd_megakernel, hipFuncAttributeMaxDynamicSharedMemorySize, LDS_BYTES) != hipSuccess) { fprintf(stderr, "kernel_launch: hipFuncSetAttribute failed\n"); grid = -1; return; }
        if (hipOccupancyMaxActiveBlocksPerMultiprocessor(&per_cu, (const void*)fwd_megakernel, NWAVES * 64, LDS_BYTES) != hipSuccess || per_cu < 1) { fprintf(stderr, "kernel_launch: occupancy query says %d blocks per CU\n", per_cu); (void)hipGetLastError(); grid = -1; return; }
        grid = cus * per_cu;
    }
    if (grid < 0) return;
    if (hipMemsetAsync((char*)d_ws + WS_CTL, 0, CTL_ZERO_BYTES, stream) != hipSuccess) { fprintf(stderr, "kernel_launch: hipMemsetAsync failed\n"); return; }
    Args a{};
    for (int i = 0; i < 9; ++i) a.in[i] = (const float*)d_in[i];
    a.out = (float*)d_out; a.ws = (unsigned char*)d_ws;
    void* args[] = {&a};
    hipError_t e = hipLaunchCooperativeKernel((const void*)fwd_megakernel, dim3(grid), dim3(NWAVES * 64), args, LDS_BYTES, stream);
    if (e != hipSuccess) fprintf(stderr, "kernel_launch: cooperative launch failed: %s (grid %d)\n", hipGetErrorString(e), grid);
}
```

```cpp
#include <hip/hip_runtime.h>
#include <cstdio>
#include <cstdint>

constexpr int NB = 8, SEQ = 4096, DM = 1024, MTOK = NB * SEQ, NLAYER = 2, INW = 9224, BW = 512;
constexpr float LOG2E = 1.4426950408889634f;
constexpr float QSCALE = 0.125f * LOG2E;
constexpr float RMS_EPS = 1e-6f;
constexpr size_t MiB = 1u << 20;
constexpr size_t WS_CTL = 0;
constexpr size_t WS_ALIBI = 512 * 1024;
constexpr size_t WS_W = 1 * MiB, W_LAYER = 23 * MiB;
constexpr size_t W_QKV = 0, W_ZG = 9 * MiB, W_B = 18 * MiB, W_O = 21 * MiB;
constexpr size_t WS_LOGF = 47 * MiB, WS_CL2 = 48 * MiB, WS_LSE = 49 * MiB;
constexpr size_t WS_XN = 52 * MiB;
constexpr size_t WS_QKV = 116 * MiB, QKV_BUF = 32 * MiB;
constexpr size_t WS_GATES = WS_QKV + 3 * QKV_BUF;
constexpr size_t WS_DILO = 404 * MiB;
constexpr size_t WS_END = 500 * MiB;
constexpr size_t CTL_ZERO_BYTES = 65536;
constexpr int CW_BAR = 4096;
constexpr int CW_QUEUE = 64;
constexpr int CW_LAM = 256;
namespace pg8 {
#define PG8_LAS __attribute__((address_space(3)))
typedef unsigned short bf16_t;
typedef short bf16x8 __attribute__((ext_vector_type(8)));
typedef float f32x4 __attribute__((ext_vector_type(4)));
typedef unsigned u32x4 __attribute__((ext_vector_type(4)));
constexpr int BM = 256, BK = 64, HALF = 128, HTB = HALF * BK * 2  , STAGE_BYTES = 8 * HTB, NXCD = 8, WGM = 8;

__host__ __device__ __forceinline__ int lds_byte(int r, int c) { const int st = (r >> 4) * 2 + (c >> 5), rr = r & 15, cc = c & 31, ob = rr * 64 + cc * 2; return st * 1024 + (ob ^ (((ob >> 9) & 1) << 5)); }
__host__ __device__ __forceinline__ void stage_rc(int b, int& R, int& C) { const int st = b / 1024, sb = b % 1024, swz = sb ^ (((sb >> 9) & 1) << 5); R = (st >> 1) * 16 + swz / 64; C = (st & 1) * 32 + (swz % 64) / 2; }
__host__ __device__ __forceinline__ int perm32(int rho) { const int n = rho >> 4, i = rho & 15; return 8 * (i >> 2) + 4 * n + (i & 3); }

struct Unit { int pm, pn; };
struct Gemm { const bf16_t* A; const bf16_t* Bt; int M, N, K; };

struct StaticOrder {
    int nM, nN, nwg, G, c;
    __host__ __device__ void init(int M, int N, int G_, int c_) { nM = M / BM; nN = N / BM; nwg = nM * nN; G = G_; c = c_; }
    __host__ __device__ bool next(int i, Unit& u) const {
        const long L = (long)i * G + c; if (L >= nwg) return false;
        int wgid = (int)L; { const int q = nwg / NXCD, r = nwg % NXCD, xcd = wgid % NXCD, off = wgid / NXCD; wgid = (xcd < r ? xcd * (q + 1) : r * (q + 1) + (xcd - r) * q) + off; }
        const int nig = WGM * nN, gid = wgid / nig, fm = gid * WGM, gsz = (nM - fm) < WGM ? (nM - fm) : WGM;
        u.pm = fm + ((wgid % nig) % gsz); u.pn = (wgid % nig) / gsz; return true;
    }
    __device__ __forceinline__ void a_ready(const Unit&) const {}
    __device__ __forceinline__ void done(const Unit&) const {}
};

__device__ __forceinline__ unsigned cvt_pk_bf16(float lo, float hi) { typedef float f32x2_t __attribute__((ext_vector_type(2))); typedef __bf16 bf16x2_t __attribute__((ext_vector_type(2)));
    f32x2_t v = {lo, hi}; bf16x2_t b = __builtin_convertvector(v, bf16x2_t); return __builtin_bit_cast(unsigned, b); }
__device__ __forceinline__ void unpack8(const u32x4 w, float (&f)[8]) {
    f[0] = __uint_as_float(w.x << 16); f[1] = __uint_as_float(w.x & 0xffff0000u); f[2] = __uint_as_float(w.y << 16); f[3] = __uint_as_float(w.y & 0xffff0000u);
    f[4] = __uint_as_float(w.z << 16); f[5] = __uint_as_float(w.z & 0xffff0000u); f[6] = __uint_as_float(w.w << 16); f[7] = __uint_as_float(w.w & 0xffff0000u); }
__device__ __forceinline__ u32x4 pack8(const float (&f)[8]) { u32x4 w; w.x = cvt_pk_bf16(f[0], f[1]); w.y = cvt_pk_bf16(f[2], f[3]); w.z = cvt_pk_bf16(f[4], f[5]); w.w = cvt_pk_bf16(f[6], f[7]); return w; }
__device__ __forceinline__ float sigmoid_f(float x) { return __builtin_amdgcn_rcpf(1.f + __builtin_amdgcn_exp2f(-x * LOG2E)); }

struct EpiQKV {
    static constexpr bool PERM = true, AFTER_DRAIN = false;
    bf16_t* base;
    __device__ __forceinline__ void operator()(const f32x4 (&acc)[2][2][4][2], const Unit& u, int wr, int wc, int fr, int fq) const {
        const int row0 = u.pm * BM + wr * 64 + fr;
        bf16_t* b = base + (size_t)(u.pn >> 1) * ((size_t)MTOK * 512);
        const float sc = u.pn < 6 ? QSCALE : 1.f;
        const int col0 = (u.pn & 1) * 256 + wc * 32 + 8 * fq;
#pragma unroll
        for (int ai = 0; ai < 2; ++ai)
#pragma unroll
            for (int m = 0; m < 4; ++m) { bf16_t* rowp = b + (size_t)(row0 + ai * HALF + m * 16) * 512 + col0;
#pragma unroll
                for (int bj = 0; bj < 2; ++bj) { f32x4 v0 = acc[ai][bj][m][0], v1 = acc[ai][bj][m][1]; asm volatile("" : "+v"(v0), "+v"(v1)); v0 = v0 * sc; v1 = v1 * sc;
                    float f[8] = {v0[0], v0[1], v0[2], v0[3], v1[0], v1[1], v1[2], v1[3]};
                    *(u32x4*)(rowp + bj * HALF) = pack8(f); }
                asm volatile("" ::: "memory"); }
    }
};

struct EpiZG {
    static constexpr bool PERM = true, AFTER_DRAIN = false;
    bf16_t* qkv; bf16_t* gates; const bf16_t* dilo; const float* lse;
    __device__ __forceinline__ void operator()(const f32x4 (&acc)[2][2][4][2], const Unit& u, int wr, int wc, int fr, int fq) const {
        const int row0 = u.pm * BM + wr * 64 + fr;
        if (u.pn < 4) {
            bf16_t* yb = qkv + (size_t)(u.pn >> 1) * ((size_t)MTOK * 512);
            const unsigned off0 = (unsigned)row0 * 512u + (unsigned)((u.pn & 1) * 256 + wc * 32 + 8 * fq);
#pragma unroll
            for (int ai = 0; ai < 2; ++ai) {
                u32x4 ov[4][2];
#pragma unroll
                for (int m = 0; m < 4; ++m)
#pragma unroll
                    for (int bj = 0; bj < 2; ++bj) ov[m][bj] = *(const u32x4*)(yb + off0 + (unsigned)((ai * HALF + m * 16) * 512 + bj * HALF));
                asm volatile("" ::: "memory");
#pragma unroll
                for (int m = 0; m < 4; ++m) {
#pragma unroll
                    for (int bj = 0; bj < 2; ++bj) { const unsigned off = off0 + (unsigned)((ai * HALF + m * 16) * 512 + bj * HALF); float o[8];
                        unpack8(ov[m][bj], o);
                        const f32x4 z0 = acc[ai][bj][m][0], z1 = acc[ai][bj][m][1];
                        f32x4 e0 = z0 * (-LOG2E), e1 = z1 * (-LOG2E); asm volatile("" : "+v"(e0), "+v"(e1));
#pragma unroll
                        for (int i = 0; i < 4; ++i) { e0[i] = __builtin_amdgcn_exp2f(e0[i]); e1[i] = __builtin_amdgcn_exp2f(e1[i]); }
                        e0 = e0 + 1.f; e1 = e1 + 1.f; asm volatile("" : "+v"(e0), "+v"(e1));
#pragma unroll
                        for (int i = 0; i < 4; ++i) { e0[i] = __builtin_amdgcn_rcpf(e0[i]); e1[i] = __builtin_amdgcn_rcpf(e1[i]); }
                        const f32x4 o0 = {o[0], o[1], o[2], o[3]}, o1 = {o[4], o[5], o[6], o[7]};
                        const f32x4 y0 = (o0 * z0) * e0, y1 = (o1 * z1) * e1;
                        const float y[8] = {y0[0], y0[1], y0[2], y0[3], y1[0], y1[1], y1[2], y1[3]};
                        *(u32x4*)(yb + off) = pack8(y); }
                    asm volatile("" ::: "memory"); } }
        } else if (u.pn < 6) {
            bf16_t* yb = qkv + (size_t)2 * ((size_t)MTOK * 512);
            const unsigned off0 = (unsigned)row0 * 512u + (unsigned)((u.pn & 1) * 256 + wc * 32 + 8 * fq);
            const int hd0 = (u.pn & 1) * 4 + (wc >> 1);
#pragma unroll
            for (int ai = 0; ai < 2; ++ai)
#pragma unroll
                for (int m = 0; m < 4; ++m) {
                    u32x4 dv[2][3]; float lv[2][3]; const int rr = ai * HALF + m * 16;
#pragma unroll
                    for (int bj = 0; bj < 2; ++bj) { const unsigned off = off0 + (unsigned)(rr * 512 + bj * HALF);
#pragma unroll
                        for (int p = 0; p < 3; ++p) { dv[bj][p] = *(const u32x4*)(dilo + (size_t)p * ((size_t)MTOK * 512) + off); lv[bj][p] = lse[((size_t)p * MTOK + (size_t)(row0 + rr)) * 8 + hd0 + 2 * bj]; } }
                    asm volatile("" ::: "memory");
#pragma unroll
                    for (int bj = 0; bj < 2; ++bj) { const unsigned off = off0 + (unsigned)(rr * 512 + bj * HALF);
                        const float l0 = lv[bj][0], l1 = lv[bj][1], l2 = lv[bj][2]; const float mx = fmaxf(fmaxf(l0, l1), l2);
                        float w0 = __builtin_amdgcn_exp2f(l0 - mx), w1 = __builtin_amdgcn_exp2f(l1 - mx), w2 = __builtin_amdgcn_exp2f(l2 - mx);
                        const float inv = 1.f / (w0 + w1 + w2); w0 *= inv; w1 *= inv; w2 *= inv;
                        float a0[8], a1[8], a2[8]; unpack8(dv[bj][0], a0); unpack8(dv[bj][1], a1); unpack8(dv[bj][2], a2);
                        const f32x4 z0 = acc[ai][bj][m][0], z1 = acc[ai][bj][m][1];
                        f32x4 e0 = z0 * (-LOG2E), e1 = z1 * (-LOG2E); asm volatile("" : "+v"(e0), "+v"(e1));
#pragma unroll
                        for (int i = 0; i < 4; ++i) { e0[i] = __builtin_amdgcn_exp2f(e0[i]); e1[i] = __builtin_amdgcn_exp2f(e1[i]); }
                        e0 = e0 + 1.f; e1 = e1 + 1.f; asm volatile("" : "+v"(e0), "+v"(e1));
#pragma unroll
                        for (int i = 0; i < 4; ++i) { e0[i] = __builtin_amdgcn_rcpf(e0[i]); e1[i] = __builtin_amdgcn_rcpf(e1[i]); }
                        const f32x4 o0 = (f32x4){a0[0], a0[1], a0[2], a0[3]} * w0 + (f32x4){a1[0], a1[1], a1[2], a1[3]} * w1 + (f32x4){a2[0], a2[1], a2[2], a2[3]} * w2;
                        const f32x4 o1 = (f32x4){a0[4], a0[5], a0[6], a0[7]} * w0 + (f32x4){a1[4], a1[5], a1[6], a1[7]} * w1 + (f32x4){a2[4], a2[5], a2[6], a2[7]} * w2;
                        const f32x4 y0 = (o0 * z0) * e0, y1 = (o1 * z1) * e1;
                        const float y[8] = {y0[0], y0[1], y0[2], y0[3], y1[0], y1[1], y1[2], y1[3]};
                        *(u32x4*)(yb + off) = pack8(y); }
                    asm volatile("" ::: "memory"); }
        } else {
            const unsigned off0 = (unsigned)row0 * 3072u + (unsigned)((u.pn - 6) * 256 + wc * 32 + 8 * fq);
#pragma unroll
            for (int ai = 0; ai < 2; ++ai)
#pragma unroll
                for (int m = 0; m < 4; ++m) {
#pragma unroll
                    for (int bj = 0; bj < 2; ++bj) { const unsigned off = off0 + (unsigned)((ai * HALF + m * 16) * 3072 + bj * HALF);
                        f32x4 e0 = acc[ai][bj][m][0] * (-LOG2E), e1 = acc[ai][bj][m][1] * (-LOG2E); asm volatile("" : "+v"(e0), "+v"(e1));
#pragma unroll
                        for (int i = 0; i < 4; ++i) { e0[i] = __builtin_amdgcn_exp2f(e0[i]); e1[i] = __builtin_amdgcn_exp2f(e1[i]); }
                        e0 = e0 + 1.f; e1 = e1 + 1.f; asm volatile("" : "+v"(e0), "+v"(e1));
                        float g[8] = {__builtin_amdgcn_rcpf(e0[0]), __builtin_amdgcn_rcpf(e0[1]), __builtin_amdgcn_rcpf(e0[2]), __builtin_amdgcn_rcpf(e0[3]), __builtin_amdgcn_rcpf(e1[0]), __builtin_amdgcn_rcpf(e1[1]), __builtin_amdgcn_rcpf(e1[2]), __builtin_amdgcn_rcpf(e1[3])};
                        *(u32x4*)(gates + off) = pack8(g); }
                    asm volatile("" ::: "memory"); }
        }
    }
};

template <int NBR> struct EpiBranch {
    static constexpr bool PERM = true, AFTER_DRAIN = false;
    const bf16_t* gates; bf16_t* merged;
    __device__ __forceinline__ void operator()(const f32x4 (&acc)[2][2][4][2], const Unit& u, int wr, int wc, int fr, int fq) const {
        const int row0 = u.pm * BM + wr * 64 + fr; const int col0 = u.pn * BM + wc * 32 + 8 * fq;
#pragma unroll
        for (int ai = 0; ai < 2; ++ai) {
            u32x4 gv[4][2], mv[4][2];
#pragma unroll
            for (int m = 0; m < 4; ++m)
#pragma unroll
                for (int bj = 0; bj < 2; ++bj) { const int row = row0 + ai * HALF + m * 16, col = col0 + bj * HALF;
                    gv[m][bj] = *(const u32x4*)(gates + (size_t)row * 3072 + NBR * 1024 + col);
                    if (NBR > 0) mv[m][bj] = *(const u32x4*)(merged + (size_t)row * 1024 + col); }
            asm volatile("" ::: "memory");
#pragma unroll
            for (int m = 0; m < 4; ++m) { const int row = row0 + ai * HALF + m * 16;
#pragma unroll
                for (int bj = 0; bj < 2; ++bj) { const int col = col0 + bj * HALF;
                    float g[8]; unpack8(gv[m][bj], g);
                    f32x4 v0 = acc[ai][bj][m][0], v1 = acc[ai][bj][m][1]; asm volatile("" : "+v"(v0), "+v"(v1));
                    float r[8] = {g[0] * v0[0], g[1] * v0[1], g[2] * v0[2], g[3] * v0[3], g[4] * v1[0], g[5] * v1[1], g[6] * v1[2], g[7] * v1[3]};
                    bf16_t* mp = merged + (size_t)row * 1024 + col;
                    if (NBR > 0) { float old[8]; unpack8(mv[m][bj], old);
#pragma unroll
                        for (int i = 0; i < 8; ++i) r[i] += old[i]; }
                    *(u32x4*)mp = pack8(r); }
                asm volatile("" ::: "memory"); } }
    }
};

struct EpiOut {
    static constexpr bool PERM = false, AFTER_DRAIN = false;
    const float* xin; float* xout;
    __device__ __forceinline__ void operator()(const f32x4 (&acc)[2][2][4][2], const Unit& u, int wr, int wc, int fr, int fq) const {
        const int row0 = u.pm * BM + wr * 64 + fr; const int col0 = u.pn * BM + wc * 32 + 4 * fq;
#pragma unroll
        for (int ai = 0; ai < 2; ++ai) {
            f32x4 xv[4][2][2];
#pragma unroll
            for (int m = 0; m < 4; ++m)
#pragma unroll
                for (int bj = 0; bj < 2; ++bj)
#pragma unroll
                    for (int n = 0; n < 2; ++n) xv[m][bj][n] = *(const f32x4*)(xin + (size_t)(row0 + ai * HALF + m * 16) * 1024 + col0 + bj * HALF + n * 16);
            asm volatile("" ::: "memory");
#pragma unroll
            for (int m = 0; m < 4; ++m) { const size_t off = (size_t)(row0 + ai * HALF + m * 16) * 1024 + col0;
#pragma unroll
                for (int bj = 0; bj < 2; ++bj)
#pragma unroll
                    for (int n = 0; n < 2; ++n) { const size_t o2 = off + bj * HALF + n * 16; *(f32x4*)(xout + o2) = xv[m][bj][n] + acc[ai][bj][m][n]; }
                asm volatile("" ::: "memory"); } }
    }
};


template <class Epi, class Sched, bool ALIGN_EPI = false, bool SP2 = false>
__device__ __forceinline__ void gemm_phase(PG8_LAS unsigned char* lds, const Gemm g, const Sched& S, const Epi& E) {
    int tid_l = threadIdx.x; asm volatile("" : "+v"(tid_l));
    const int tid = tid_l, wid = __builtin_amdgcn_readfirstlane(tid >> 6), lane = tid & 63, wr = wid >> 2, wc = wid & 3, fr = lane & 15, fq = lane >> 4;
    const int K = g.K, nt = K / BK;
    unsigned voffA[2], voffB[2];
#pragma unroll
    for (int i = 0; i < 2; ++i) { int R, C; stage_rc(tid * 16 + i * 8192, R, C); const int Rb = Epi::PERM ? ((R & ~31) + perm32(R & 31)) : R;
        voffA[i] = (unsigned)(R * K + C) * 2u; voffB[i] = (unsigned)(Rb * K + C) * 2u; }
    const size_t kstep = (size_t)(BK * 2);
    const size_t hstep = (size_t)HALF * K * 2;
    const size_t tstep = 2 * hstep;
    const unsigned ldsw = (unsigned)wid * 1024u;
    const int aoff = lds_byte(wr * 64 + fr, fq * 8), boff = lds_byte(wc * 32 + fr, fq * 8);
#define PG8_SA(b, h) (((b) * 2 + (h)) * HTB)
#define PG8_SB(b, h) ((4 + (b) * 2 + (h)) * HTB)
#define PG8_STAGE(bufoff, gbase, voff) do { _Pragma("unroll") for (int _i = 0; _i < 2; ++_i) \
        __builtin_amdgcn_global_load_lds((const unsigned*)((const char*)(gbase) + (voff)[_i]), (PG8_LAS unsigned*)(lds + (bufoff) + ldsw + _i * 8192), 16, 0, 0); } while (0)
#define PG8_LDA(dst, b, h) do { _Pragma("unroll") for (int m = 0; m < 4; ++m) _Pragma("unroll") for (int k = 0; k < 2; ++k) dst[m][k] = *(const PG8_LAS bf16x8*)(lds + PG8_SA(b, h) + aoff + m * 2048 + k * 1024); } while (0)
#define PG8_LDB(dst, b, h) do { _Pragma("unroll") for (int n = 0; n < 2; ++n) _Pragma("unroll") for (int k = 0; k < 2; ++k) dst[n][k] = *(const PG8_LAS bf16x8*)(lds + PG8_SB(b, h) + boff + n * 2048 + k * 1024); } while (0)
#define PG8_MMA(ai, bj, At, Bt) do { __builtin_amdgcn_s_setprio(1); _Pragma("unroll") for (int m = 0; m < 4; ++m) _Pragma("unroll") for (int n = 0; n < 2; ++n) _Pragma("unroll") for (int k = 0; k < 2; ++k) \
        acc[ai][bj][m][n] = __builtin_amdgcn_mfma_f32_16x16x32_bf16(Bt[n][k], At[m][k], acc[ai][bj][m][n], 0, 0, 0); __builtin_amdgcn_s_setprio(0); } while (0)
#define PG8_WAIT_V(n) asm volatile("s_waitcnt vmcnt(" #n ")" ::: "memory")
#define PG8_WAIT_L(n) asm volatile("s_waitcnt lgkmcnt(" #n ")" ::: "memory")
#define PG8_BAR __builtin_amdgcn_s_barrier()
#define PG8_SCHED __builtin_amdgcn_sched_barrier(0)
    Unit cur, nxt; int ui = 0;
    if (!S.next(0, cur)) return;
    f32x4 acc[2][2][4][2];
#pragma unroll
    for (int a = 0; a < 2; ++a)
#pragma unroll
        for (int b = 0; b < 2; ++b)
#pragma unroll
            for (int m = 0; m < 4; ++m)
#pragma unroll
                for (int n = 0; n < 2; ++n) acc[a][b][m][n] = (f32x4){0.f, 0.f, 0.f, 0.f};
    bf16x8 At[4][2], B0[2][2], B1[2][2];
    const char* cA = (const char*)g.A + (size_t)cur.pm * tstep; const char* cB = (const char*)g.Bt + (size_t)cur.pn * tstep;
    S.a_ready(cur);
    if constexpr (SP2) {
        PG8_STAGE(PG8_SB(0, 0), cB, voffB); PG8_STAGE(PG8_SB(0, 1), cB + hstep, voffB); PG8_STAGE(PG8_SA(0, 0), cA, voffA); PG8_STAGE(PG8_SA(0, 1), cA + hstep, voffA);
        if (wr == 1) PG8_BAR;
        PG8_WAIT_V(2); PG8_BAR;
        PG8_STAGE(PG8_SB(1, 0), cB + kstep, voffB); PG8_STAGE(PG8_SA(1, 0), cA + kstep, voffA); PG8_STAGE(PG8_SB(1, 1), cB + hstep + kstep, voffB);
        PG8_WAIT_V(6); PG8_BAR;
    } else {
        PG8_STAGE(PG8_SB(0, 0), cB, voffB); PG8_STAGE(PG8_SA(0, 0), cA, voffA); PG8_STAGE(PG8_SB(0, 1), cB + hstep, voffB); PG8_STAGE(PG8_SA(0, 1), cA + hstep, voffA);
        if (wr == 1) PG8_BAR;
        PG8_WAIT_V(4); PG8_BAR;
        PG8_STAGE(PG8_SB(1, 0), cB + kstep, voffB); PG8_STAGE(PG8_SA(1, 0), cA + kstep, voffA); PG8_STAGE(PG8_SB(1, 1), cB + hstep + kstep, voffB);
        PG8_WAIT_V(6); PG8_BAR;
    }
    for (;;) {
        const bool has_next = S.next(ui + 1, nxt);
        const char* nA = has_next ? (const char*)g.A + (size_t)nxt.pm * tstep : cA; const char* nB = has_next ? (const char*)g.Bt + (size_t)nxt.pn * tstep : cB;
        for (int t = 0; t < nt; t += 2) {
            const bool last = (t == nt - 2);
            const char* a1 = cA + (size_t)(t + 1) * kstep;
            const char* a2 = last ? nA : cA + (size_t)(t + 2) * kstep; const char* b2 = last ? nB : cB + (size_t)(t + 2) * kstep;
            const char* a3 = a2 + kstep; const char* b3 = b2 + kstep;
            if (last && has_next) S.a_ready(nxt);
            if constexpr (SP2) {
            PG8_LDB(B0, 0, 0); PG8_LDB(B1, 0, 1); PG8_SCHED; PG8_LDA(At, 0, 0); PG8_STAGE(PG8_SA(1, 1), a1 + hstep, voffA);
            PG8_WAIT_V(8); PG8_WAIT_L(0); PG8_BAR; PG8_MMA(0, 0, At, B0); PG8_MMA(0, 1, At, B1); PG8_BAR; PG8_SCHED;
            PG8_LDA(At, 0, 1); PG8_STAGE(PG8_SB(0, 0), b2, voffB); PG8_STAGE(PG8_SB(0, 1), b2 + hstep, voffB); PG8_STAGE(PG8_SA(0, 0), a2, voffA);
            PG8_WAIT_V(8); PG8_WAIT_L(0); PG8_BAR; PG8_MMA(1, 0, At, B0); PG8_MMA(1, 1, At, B1); PG8_BAR; PG8_SCHED;
            PG8_LDB(B0, 1, 0); PG8_LDB(B1, 1, 1); PG8_SCHED; PG8_LDA(At, 1, 0); PG8_STAGE(PG8_SA(0, 1), a2 + hstep, voffA);
            PG8_WAIT_V(8); PG8_WAIT_L(0); PG8_BAR; PG8_MMA(0, 0, At, B0); PG8_MMA(0, 1, At, B1); PG8_BAR; PG8_SCHED;
            PG8_LDA(At, 1, 1); PG8_STAGE(PG8_SB(1, 0), b3, voffB); PG8_STAGE(PG8_SB(1, 1), b3 + hstep, voffB); PG8_STAGE(PG8_SA(1, 0), a3, voffA);
            PG8_WAIT_V(8); PG8_WAIT_L(0); PG8_BAR; PG8_MMA(1, 0, At, B0); PG8_MMA(1, 1, At, B1); PG8_BAR; PG8_SCHED;
            } else {
            PG8_LDB(B0, 0, 0); PG8_SCHED; PG8_LDA(At, 0, 0); PG8_STAGE(PG8_SA(1, 1), a1 + hstep, voffA);
            PG8_WAIT_L(8); PG8_BAR; PG8_WAIT_L(0); PG8_MMA(0, 0, At, B0); PG8_BAR; PG8_SCHED;
            PG8_LDB(B1, 0, 1); PG8_STAGE(PG8_SB(0, 0), b2, voffB);
            PG8_BAR; PG8_WAIT_L(0); PG8_MMA(0, 1, At, B1); PG8_BAR;
            PG8_LDA(At, 0, 1); PG8_STAGE(PG8_SA(0, 0), a2, voffA);
            PG8_BAR; PG8_WAIT_L(0); PG8_MMA(1, 0, At, B0); PG8_BAR; PG8_SCHED;
            PG8_STAGE(PG8_SB(0, 1), b2 + hstep, voffB);
            PG8_WAIT_V(6); PG8_BAR; PG8_MMA(1, 1, At, B1); PG8_BAR;
            PG8_LDB(B0, 1, 0); PG8_SCHED; PG8_LDA(At, 1, 0); PG8_STAGE(PG8_SA(0, 1), a2 + hstep, voffA);
            PG8_WAIT_L(8); PG8_BAR; PG8_WAIT_L(0); PG8_MMA(0, 0, At, B0); PG8_BAR; PG8_SCHED;
            PG8_LDB(B1, 1, 1); PG8_STAGE(PG8_SB(1, 0), b3, voffB);
            PG8_BAR; PG8_WAIT_L(0); PG8_MMA(0, 1, At, B1); PG8_BAR;
            PG8_LDA(At, 1, 1); PG8_STAGE(PG8_SA(1, 0), a3, voffA);
            PG8_BAR; PG8_WAIT_L(0); PG8_MMA(1, 0, At, B0); PG8_BAR; PG8_SCHED;
            PG8_STAGE(PG8_SB(1, 1), b3 + hstep, voffB);
            PG8_WAIT_V(6); PG8_BAR; PG8_MMA(1, 1, At, B1); PG8_BAR;
            }
        }
        if constexpr (ALIGN_EPI) { if (wr == 0) PG8_BAR; }
        if constexpr (!Epi::AFTER_DRAIN) { E(acc, cur, wr, wc, fr, fq); S.done(cur); }
        if (!has_next) break;
#pragma unroll
        for (int a = 0; a < 2; ++a)
#pragma unroll
            for (int b = 0; b < 2; ++b)
#pragma unroll
                for (int m = 0; m < 4; ++m)
#pragma unroll
                    for (int n = 0; n < 2; ++n) acc[a][b][m][n] = (f32x4){0.f, 0.f, 0.f, 0.f};
        cur = nxt; cA = nA; cB = nB; ++ui;
        if constexpr (ALIGN_EPI) { if (wr == 1) PG8_BAR; }
    }
    PG8_WAIT_V(0);
    if constexpr (!ALIGN_EPI) { if (wr == 0) PG8_BAR; }
    PG8_BAR;
    if constexpr (Epi::AFTER_DRAIN) { E.fused(acc, cur, wr, wc, fr, fq, lds, wid, lane); S.done(cur); }
#undef PG8_SA
#undef PG8_SB
#undef PG8_STAGE
#undef PG8_LDA
#undef PG8_LDB
#undef PG8_MMA
#undef PG8_WAIT_V
#undef PG8_WAIT_L
#undef PG8_BAR
#undef PG8_SCHED
}
}

namespace att {
#define LAS __attribute__((address_space(3)))
typedef unsigned short bf16_t;
typedef short bf16x8 __attribute__((ext_vector_type(8)));
typedef short s16x4 __attribute__((ext_vector_type(4)));
typedef short v4i16_t __attribute__((ext_vector_type(4)));
typedef float f32x16 __attribute__((ext_vector_type(16)));
typedef float f32x4 __attribute__((ext_vector_type(4)));
typedef unsigned u32x4 __attribute__((ext_vector_type(4)));
typedef unsigned u32x2 __attribute__((ext_vector_type(2)));
constexpr int L_K = 0, L_V = 16384, L_B = 49152, L_MISC = 49152 + 512;
constexpr float ATT_THR = 64.f;
constexpr int L2_K = 0, L2_V = 32768;
constexpr int L_OA = 65536;
constexpr int ATT_LDS_BYTES = L_OA + 65536;

__device__ __forceinline__ int crow(int r, int hi) { return (r & 3) + 8 * (r >> 2) + 4 * hi; }
__device__ __forceinline__ unsigned cvtpk(float lo, float hi) { typedef float f32x2_t __attribute__((ext_vector_type(2))); typedef __bf16 bf16x2_t __attribute__((ext_vector_type(2)));
    f32x2_t v = {lo, hi}; bf16x2_t b = __builtin_convertvector(v, bf16x2_t); return __builtin_bit_cast(unsigned, b); }
__device__ __forceinline__ s16x4 vtr(const LAS char* p) { return __builtin_bit_cast(s16x4, __builtin_amdgcn_ds_read_tr16_b64_v4i16((LAS v4i16_t*)p)); }
typedef float f32x8_t __attribute__((ext_vector_type(8))); typedef float f32x4_t __attribute__((ext_vector_type(4))); typedef float f32x2_t __attribute__((ext_vector_type(2)));
__device__ __forceinline__ float hsum16(const f32x16 s) {
    const f32x8_t a = __builtin_shufflevector(s, s, 0, 1, 2, 3, 4, 5, 6, 7) + __builtin_shufflevector(s, s, 8, 9, 10, 11, 12, 13, 14, 15);
    const f32x4_t b = __builtin_shufflevector(a, a, 0, 1, 2, 3) + __builtin_shufflevector(a, a, 4, 5, 6, 7);
    const f32x2_t c = __builtin_shufflevector(b, b, 0, 1) + __builtin_shufflevector(b, b, 2, 3);
    return c[0] + c[1]; }
__device__ __forceinline__ float half_max(float v) { auto rr = __builtin_amdgcn_permlane32_swap(__float_as_uint(v), __float_as_uint(v), false, false); return fmaxf(__uint_as_float(rr[0]), __uint_as_float(rr[1])); }
__device__ __forceinline__ float half_sum(float v) { auto rr = __builtin_amdgcn_permlane32_swap(__float_as_uint(v), __float_as_uint(v), false, false); return __uint_as_float(rr[0]) + __uint_as_float(rr[1]); }
#define MFMA32(a, b, c) __builtin_amdgcn_mfma_f32_32x32x16_bf16(a, b, c, 0, 0, 0)

struct PassArgs {
    const bf16_t* q;
    const bf16_t* k;
    const bf16_t* v;
    long kpitch;
    const float* kbias;
    float qbias;
    float slope2;
    int q0;
};

template <int DV, int MODE>
__device__ __forceinline__ void attn_pass(LAS char* lds, const PassArgs& a, f32x16 (&o)[DV / 32], float& m_out, float& l_out, const int tid) {
    const int lane = tid & 63, r32 = lane & 31, hi = lane >> 5;
    const int w = __builtin_amdgcn_readfirstlane(tid >> 6);
    const int qw0 = a.q0 + 32 * w, myq = qw0 + r32;
    const int t_begin = (MODE == 2 && a.q0 >= 256) ? ((a.q0 - 128) >> 6) : 0;
    const int t_end = (a.q0 + 256) >> 6;
    const int tw_hi = (qw0 + 31) >> 6;
    const int tw_lo = (MODE == 2 && qw0 > 128) ? ((qw0 - 128) >> 6) : 0;
    bf16x8 qf[4];
#pragma unroll
    for (int d0 = 0; d0 < 4; ++d0) qf[d0] = *(const bf16x8*)(a.q + d0 * 16 + hi * 8);
#pragma unroll
    for (int i = 0; i < DV / 32; ++i)
#pragma unroll
        for (int g = 0; g < 16; ++g) o[i][g] = 0.f;
    float m = -1e30f, l = 0.f;
    f32x16 kc;
#pragma unroll
    for (int g = 0; g < 16; ++g) kc[g] = (MODE == 1) ? 0.f : a.slope2 * (float)((g & 3) + 8 * (g >> 2) + 4 * hi);
    const bf16_t* ksrc = a.k + (long)lane * a.kpitch + 8 * w;
    const bf16_t* vsrc = a.v + (long)(16 * (w & 3) + (lane >> 2)) * a.kpitch + 32 * (w >> 2) + 8 * (lane & 3);
    const long tstride = 64 * a.kpitch;
#define ATT_ISSUE(t, buf) do { \
        __builtin_amdgcn_global_load_lds((const unsigned*)(ksrc + (long)(t) * tstride), (LAS unsigned*)(lds + L_K + (buf) * 8192 + w * 1024), 16, 0, 0); \
        __builtin_amdgcn_global_load_lds((const unsigned*)(vsrc + (long)(t) * tstride), (LAS unsigned*)(lds + L_V + (buf) * 16384 + w * 1024), 16, 0, 0); \
        if (DV == 128) __builtin_amdgcn_global_load_lds((const unsigned*)(vsrc + (long)(t) * tstride + 64), (LAS unsigned*)(lds + L_V + (buf) * 16384 + (w + 8) * 1024), 16, 0, 0); \
        if (MODE == 1) { if (w == 0) __builtin_amdgcn_global_load_lds((const unsigned*)(a.kbias + (t) * 64 + lane), (LAS unsigned*)(lds + L_B + (buf) * 256), 4, 0, 0); } \
    } while (0)
    ATT_ISSUE(t_begin, 0);
    __syncthreads();
    const int vlane = ((lane >> 4) & 1) * 32 + (lane & 3) * 8 + (4 * hi + ((lane & 15) >> 2)) * 64;
    for (int t = t_begin; t < t_end; ++t) {
        const int buf = (t - t_begin) & 1;
        if (t + 1 < t_end) ATT_ISSUE(t + 1, buf ^ 1);
        if (t >= tw_lo && t <= tw_hi) {
            const LAS char* kb = lds + L_K + buf * 8192 + hi * 1024 + r32 * 16;
            f32x16 p0, p1;
#pragma unroll
            for (int d0 = 0; d0 < 4; ++d0) {
                const bf16x8 k0 = *(const LAS bf16x8*)(kb + d0 * 2048), k1 = *(const LAS bf16x8*)(kb + d0 * 2048 + 512);
                if (d0 == 0) { p0 = MFMA32(k0, qf[0], kc); p1 = MFMA32(k1, qf[0], kc); }
                else { p0 = MFMA32(k0, qf[d0], p0); p1 = MFMA32(k1, qf[d0], p1); }
            }
            __builtin_amdgcn_sched_barrier(0);
            float base, c32 = 0.f;
            if (MODE == 1) {
                const LAS char* bb = lds + L_B + buf * 256 + hi * 16;
#pragma unroll
                for (int gq = 0; gq < 4; ++gq) {
                    const f32x4 c0 = *(const LAS f32x4*)(bb + gq * 32), c1 = *(const LAS f32x4*)(bb + 128 + gq * 32);
#pragma unroll
                    for (int j = 0; j < 4; ++j) { p0[4 * gq + j] -= c0[j]; p1[4 * gq + j] -= c1[j]; }
                }
                base = a.qbias;
            } else {
                base = a.slope2 * (float)(64 * t - myq); c32 = 32.f * a.slope2;
            }
            const bool bnd = (64 * t + 63 > qw0) || (MODE == 2 && 64 * t < qw0 + 31 - 128);
            if (bnd) {
                const int dq = myq - 64 * t - 4 * hi;
#pragma unroll
                for (int g = 0; g < 16; ++g) {
                    const int cg = (g & 3) + 8 * (g >> 2);
                    const bool v0 = MODE == 2 ? ((unsigned)(dq - cg) <= 128u) : (cg <= dq);
                    const bool v1 = MODE == 2 ? ((unsigned)(dq - cg - 32) <= 128u) : (cg + 32 <= dq);
                    p0[g] = v0 ? p0[g] : -INFINITY; p1[g] = v1 ? p1[g] : -INFINITY;
                }
            }
            float mx0 = p0[0], mx1 = p1[0];
#pragma unroll
            for (int g = 1; g < 16; ++g) { mx0 = fmaxf(mx0, p0[g]); mx1 = fmaxf(mx1, p1[g]); }
            float mx = half_max(fmaxf(mx0, mx1 + c32));
            const float mt_ = mx + base; const float mnew = (mt_ > m + ATT_THR) ? mt_ : m;
            const float alpha = __builtin_amdgcn_exp2f(m - mnew);
            const float mb = mnew - base, mb1 = mb - c32;
            { float nmb = -mb, nmb1 = -mb1; asm volatile("" : "+v"(nmb), "+v"(nmb1)); p0 = p0 + nmb; p1 = p1 + nmb1; }
#pragma unroll
            for (int g = 0; g < 16; ++g) { p0[g] = __builtin_amdgcn_exp2f(p0[g]); p1[g] = __builtin_amdgcn_exp2f(p1[g]); }
            const float ps = hsum16(p0 + p1);
            l = l * alpha + ps;
            if (__any(mnew > m)) {
#pragma unroll
                for (int i = 0; i < DV / 32; ++i)
#pragma unroll
                    for (int g = 0; g < 16; ++g) o[i][g] *= alpha;
            }
            m = mnew;
            u32x4 pw[4];
#pragma unroll
            for (int j = 0; j < 4; ++j) { pw[0][j] = cvtpk(p0[2 * j], p0[2 * j + 1]); pw[1][j] = cvtpk(p0[8 + 2 * j], p0[9 + 2 * j]); pw[2][j] = cvtpk(p1[2 * j], p1[2 * j + 1]); pw[3][j] = cvtpk(p1[8 + 2 * j], p1[9 + 2 * j]); }
            __builtin_amdgcn_sched_barrier(0);
            const LAS char* vb = lds + L_V + buf * 16384 + vlane;
            s16x4 lo_[2][DV / 32], hh_[2][DV / 32];
#pragma unroll
            for (int i = 0; i < DV / 32; ++i) { lo_[0][i] = vtr(vb + i * 4096); hh_[0][i] = vtr(vb + i * 4096 + 512); }
#pragma unroll
            for (int ks = 0; ks < 4; ++ks) {
                if (ks + 1 < 4) {
#pragma unroll
                    for (int i = 0; i < DV / 32; ++i) { lo_[(ks + 1) & 1][i] = vtr(vb + i * 4096 + (ks + 1) * 1024); hh_[(ks + 1) & 1][i] = vtr(vb + i * 4096 + (ks + 1) * 1024 + 512); }
                }
#pragma unroll
                for (int i = 0; i < DV / 32; ++i) { const s16x4 lo = lo_[ks & 1][i], hh = hh_[ks & 1][i]; const bf16x8 vf = (bf16x8){lo[0], lo[1], lo[2], lo[3], hh[0], hh[1], hh[2], hh[3]};
                    o[i] = MFMA32(vf, __builtin_bit_cast(bf16x8, pw[ks]), o[i]); }
                __builtin_amdgcn_sched_barrier(0);
            }
        }
        __syncthreads();
    }
#undef ATT_ISSUE
    m_out = m; l_out = l;
}


__device__ __forceinline__ void diff_unit(LAS char* lds, int b, int h, int qb, bf16_t* DQ, const bf16_t* DK, const bf16_t* DVb, float lam, float post, const float* gn) {
    int tid = threadIdx.x; asm volatile("" : "+v"(tid));
    const int lane = tid & 63, r32 = lane & 31, hi = lane >> 5;
    const int w = __builtin_amdgcn_readfirstlane(tid >> 6);
    const int q0 = qb * 256, myq = q0 + 32 * w + r32;
    const size_t tok0 = (size_t)b * SEQ;
    PassArgs a; a.kpitch = 512; a.kbias = nullptr; a.qbias = 0.f; a.q0 = q0;
    a.slope2 = __builtin_amdgcn_exp2f(-2.f * (float)(h + 1)) * LOG2E;
    a.q = DQ + (tok0 + myq) * 512 + (2 * h) * 64; a.k = DK + tok0 * 512 + (2 * h) * 64; a.v = DVb + tok0 * 512 + h * 128;
    f32x16 ob[4]; float m, l;
    LAS u32x4* oas = (LAS u32x4*)(lds + L_OA + w * 8192) + lane;
    attn_pass<128, 0>(lds, a, ob, m, l, tid);
    { const float inv = 1.f / half_sum(l);
#pragma unroll
      for (int i = 0; i < 4; ++i)
#pragma unroll
          for (int jj = 0; jj < 2; ++jj) { u32x4 wv;
#pragma unroll
              for (int j = 0; j < 4; ++j) wv[j] = cvtpk(ob[i][8 * jj + 2 * j] * inv, ob[i][8 * jj + 2 * j + 1] * inv);
              oas[(i * 2 + jj) * 64] = wv; } }
    a.q += 64; a.k += 64;
    attn_pass<128, 0>(lds, a, ob, m, l, tid);
    { const float f = lam / half_sum(l); float ss = 0.f;
#pragma unroll
      for (int i = 0; i < 4; ++i)
#pragma unroll
          for (int jj = 0; jj < 2; ++jj) { const u32x4 wv = oas[(i * 2 + jj) * 64];
#pragma unroll
              for (int j = 0; j < 4; ++j) { const float a0 = __uint_as_float(wv[j] << 16), a1 = __uint_as_float(wv[j] & 0xffff0000u); const int g = 8 * jj + 2 * j;
                  ob[i][g] = a0 - f * ob[i][g]; ob[i][g + 1] = a1 - f * ob[i][g + 1]; ss += ob[i][g] * ob[i][g] + ob[i][g + 1] * ob[i][g + 1]; } }
      ss = half_sum(ss);
      const float rr = post / sqrtf(ss * (1.f / 128.f) + RMS_EPS);
      bf16_t* orow = DQ + (tok0 + myq) * 512 + h * 128;
#pragma unroll
      for (int i = 0; i < 4; ++i)
#pragma unroll
          for (int gq = 0; gq < 4; ++gq) { const int dv0 = 32 * i + 8 * gq + 4 * hi; const f32x4 g4 = *(const f32x4*)(gn + dv0);
              u32x2 wv; wv.x = cvtpk(ob[i][4 * gq] * rr * g4[0], ob[i][4 * gq + 1] * rr * g4[1]); wv.y = cvtpk(ob[i][4 * gq + 2] * rr * g4[2], ob[i][4 * gq + 3] * rr * g4[3]);
              *(u32x2*)(orow + dv0) = wv; } }
}

__device__ __forceinline__ void store_o64(bf16_t* orow, const f32x16 (&o)[2], float inv, int hi) {
#pragma unroll
    for (int i = 0; i < 2; ++i)
#pragma unroll
        for (int gq = 0; gq < 4; ++gq) { const int dv0 = 32 * i + 8 * gq + 4 * hi;
            u32x2 wv; wv.x = cvtpk(o[i][4 * gq] * inv, o[i][4 * gq + 1] * inv); wv.y = cvtpk(o[i][4 * gq + 2] * inv, o[i][4 * gq + 3] * inv);
            *(u32x2*)(orow + dv0) = wv; }
}

__device__ __forceinline__ void fox_unit(LAS char* lds, int b, int h, int qb, bf16_t* FQ, const bf16_t* FK, const bf16_t* FV, const float* cl2) {
    int tid = threadIdx.x; asm volatile("" : "+v"(tid));
    const int lane = tid & 63, r32 = lane & 31, hi = lane >> 5;
    const int w = __builtin_amdgcn_readfirstlane(tid >> 6);
    const int q0 = qb * 256, myq = q0 + 32 * w + r32;
    const size_t tok0 = (size_t)b * SEQ;
    PassArgs a; a.kpitch = 512; a.kbias = cl2; a.qbias = cl2[myq]; a.slope2 = 0.f; a.q0 = q0;
    a.q = FQ + (tok0 + myq) * 512 + h * 64; a.k = FK + tok0 * 512 + h * 64; a.v = FV + tok0 * 512 + h * 64;
    f32x16 o[2]; float m, l;
    attn_pass<64, 1>(lds, a, o, m, l, tid);
    store_o64(FQ + (tok0 + myq) * 512 + h * 64, o, 1.f / half_sum(l), hi);
}

__device__ __forceinline__ void dil_pass2h(LAS char* lds, const PassArgs& a, f32x16 (&o)[2], float& m_out, float& l_out, const int tid) {
    const int lane = tid & 63, r32 = lane & 31, hi = lane >> 5;
    const int w = __builtin_amdgcn_readfirstlane(tid >> 6);
    const int wq = (w & 1) | ((w >> 2) << 1), hs = (w >> 1) & 1;
    const int qw0 = a.q0 + 32 * wq, myq = qw0 + r32;
    const int t_begin = a.q0 >= 128 ? ((a.q0 - 128) >> 6) : 0;
    const int t_end = (a.q0 + 128) >> 6;
    const int tw_hi = (qw0 + 31) >> 6;
    const int tw_lo = qw0 > 128 ? ((qw0 - 128) >> 6) : 0;
    bf16x8 qf[4];
#pragma unroll
    for (int d0 = 0; d0 < 4; ++d0) qf[d0] = *(const bf16x8*)(a.q + d0 * 16 + hi * 8);
#pragma unroll
    for (int i = 0; i < 2; ++i)
#pragma unroll
        for (int g = 0; g < 16; ++g) o[i][g] = 0.f;
    float m = -1e30f, l = 0.f;
    f32x16 kc;
#pragma unroll
    for (int g = 0; g < 16; ++g) kc[g] = a.slope2 * (float)((g & 3) + 8 * (g >> 2) + 4 * hi);
    const bf16_t* ksrc = a.k + (long)lane * a.kpitch + 8 * w;
    const bf16_t* vsrc = a.v + (long)(16 * (w & 3) + (lane >> 2)) * a.kpitch + 32 * (w >> 2) + 8 * (lane & 3);
    const long tstride = 64 * a.kpitch;
#define D2_ISSUE(t, buf) do { \
        __builtin_amdgcn_global_load_lds((const unsigned*)(ksrc + (long)(t) * tstride), (LAS unsigned*)(lds + L2_K + (buf) * 16384 + w * 1024), 16, 0, 0); \
        __builtin_amdgcn_global_load_lds((const unsigned*)(ksrc + (long)(t) * tstride + 64), (LAS unsigned*)(lds + L2_K + (buf) * 16384 + 8192 + w * 1024), 16, 0, 0); \
        __builtin_amdgcn_global_load_lds((const unsigned*)(vsrc + (long)(t) * tstride), (LAS unsigned*)(lds + L2_V + (buf) * 16384 + w * 1024), 16, 0, 0); \
        __builtin_amdgcn_global_load_lds((const unsigned*)(vsrc + (long)(t) * tstride + 64), (LAS unsigned*)(lds + L2_V + (buf) * 16384 + (w + 8) * 1024), 16, 0, 0); \
    } while (0)
    D2_ISSUE(t_begin, 0);
    __syncthreads();
    const int vlane = ((lane >> 4) & 1) * 32 + (lane & 3) * 8 + (4 * hi + ((lane & 15) >> 2)) * 64;
    for (int t = t_begin; t < t_end; ++t) {
        const int buf = (t - t_begin) & 1;
        if (t + 1 < t_end) D2_ISSUE(t + 1, buf ^ 1);
        if (t >= tw_lo && t <= tw_hi) {
            const LAS char* kb = lds + L2_K + buf * 16384 + hs * 8192 + hi * 1024 + r32 * 16;
            f32x16 p0, p1;
#pragma unroll
            for (int d0 = 0; d0 < 4; ++d0) {
                const bf16x8 k0 = *(const LAS bf16x8*)(kb + d0 * 2048), k1 = *(const LAS bf16x8*)(kb + d0 * 2048 + 512);
                if (d0 == 0) { p0 = MFMA32(k0, qf[0], kc); p1 = MFMA32(k1, qf[0], kc); }
                else { p0 = MFMA32(k0, qf[d0], p0); p1 = MFMA32(k1, qf[d0], p1); }
            }
            __builtin_amdgcn_sched_barrier(0);
            const float base = a.slope2 * (float)(64 * t - myq), c32 = 32.f * a.slope2;
            const bool bnd = (64 * t + 63 > qw0) || (64 * t < qw0 + 31 - 128);
            if (bnd) {
                const int dq = myq - 64 * t - 4 * hi;
#pragma unroll
                for (int g = 0; g < 16; ++g) {
                    const int cg = (g & 3) + 8 * (g >> 2);
                    const bool v0 = (unsigned)(dq - cg) <= 128u, v1 = (unsigned)(dq - cg - 32) <= 128u;
                    p0[g] = v0 ? p0[g] : -INFINITY; p1[g] = v1 ? p1[g] : -INFINITY;
                }
            }
            float mx0 = p0[0], mx1 = p1[0];
#pragma unroll
            for (int g = 1; g < 16; ++g) { mx0 = fmaxf(mx0, p0[g]); mx1 = fmaxf(mx1, p1[g]); }
            const float mx = half_max(fmaxf(mx0, mx1 + c32));
            const float mt_ = mx + base; const float mnew = (mt_ > m + ATT_THR) ? mt_ : m;
            const float alpha = __builtin_amdgcn_exp2f(m - mnew);
            const float mb = mnew - base, mb1 = mb - c32;
            { float nmb = -mb, nmb1 = -mb1; asm volatile("" : "+v"(nmb), "+v"(nmb1)); p0 = p0 + nmb; p1 = p1 + nmb1; }
#pragma unroll
            for (int g = 0; g < 16; ++g) { p0[g] = __builtin_amdgcn_exp2f(p0[g]); p1[g] = __builtin_amdgcn_exp2f(p1[g]); }
            const float ps = hsum16(p0 + p1);
            l = l * alpha + ps;
            if (__any(mnew > m)) {
#pragma unroll
                for (int i = 0; i < 2; ++i)
#pragma unroll
                    for (int g = 0; g < 16; ++g) o[i][g] *= alpha;
            }
            m = mnew;
            u32x4 pw[4];
#pragma unroll
            for (int j = 0; j < 4; ++j) { pw[0][j] = cvtpk(p0[2 * j], p0[2 * j + 1]); pw[1][j] = cvtpk(p0[8 + 2 * j], p0[9 + 2 * j]); pw[2][j] = cvtpk(p1[2 * j], p1[2 * j + 1]); pw[3][j] = cvtpk(p1[8 + 2 * j], p1[9 + 2 * j]); }
            __builtin_amdgcn_sched_barrier(0);
            const LAS char* vb = lds + L2_V + buf * 16384 + hs * 8192 + vlane;
#pragma unroll
            for (int ks = 0; ks < 4; ++ks)
#pragma unroll
                for (int i = 0; i < 2; ++i) {
                    const s16x4 lo = vtr(vb + i * 4096 + ks * 1024), hh = vtr(vb + i * 4096 + ks * 1024 + 512);
                    const bf16x8 vf = (bf16x8){lo[0], lo[1], lo[2], lo[3], hh[0], hh[1], hh[2], hh[3]};
                    o[i] = MFMA32(vf, __builtin_bit_cast(bf16x8, pw[ks]), o[i]);
                }
        }
        __syncthreads();
    }
#undef D2_ISSUE
    m_out = m; l_out = l;
}
__device__ __forceinline__ void dil_unit(LAS char* lds, int p, int b, int hp, int r, int blk, const bf16_t* CQ, const bf16_t* CK, const bf16_t* CV, bf16_t* dilo, float* lse) {
    int tid = threadIdx.x; asm volatile("" : "+v"(tid));
    const int lane = tid & 63, r32 = lane & 31, hi = lane >> 5;
    const int w = __builtin_amdgcn_readfirstlane(tid >> 6);
    const int d = 1 << (2 * p), h = 2 * hp + ((w >> 1) & 1);
    const int q0 = blk * 128, myq = q0 + 32 * ((w & 1) | ((w >> 2) << 1)) + r32;
    const size_t tok0 = (size_t)b * SEQ, tok = tok0 + (size_t)myq * d + r;
    PassArgs a; a.kpitch = 512L * d; a.kbias = nullptr; a.qbias = 0.f; a.q0 = q0;
    a.slope2 = __builtin_amdgcn_exp2f(-(float)(h + 1)) * LOG2E * (float)d;
    a.q = CQ + tok * 512 + h * 64; a.k = CK + (tok0 + r) * 512 + hp * 128; a.v = CV + (tok0 + r) * 512 + hp * 128;
    f32x16 o[2]; float m, l;
    dil_pass2h(lds, a, o, m, l, tid);
    const float lt = half_sum(l);
    store_o64(dilo + ((size_t)p * MTOK + tok) * 512 + h * 64, o, 1.f / lt, hi);
    if (hi == 0) lse[((size_t)p * MTOK + tok) * 8 + h] = m + log2f(lt);
}
constexpr int N_DIFF_UNITS = 512, N_FOX_UNITS = 1024, N_DIL_UNITS = 3072, N_ATT_UNITS = N_DIFF_UNITS + N_FOX_UNITS + N_DIL_UNITS;
#undef LAS
}

namespace af {
#define LAS __attribute__((address_space(3)))
typedef unsigned short bf16_t;
using bf16x8=__attribute__((ext_vector_type(8)))short;
using s16x4=__attribute__((ext_vector_type(4)))short;
using f32x16=__attribute__((ext_vector_type(16)))float;
using f32x4=__attribute__((ext_vector_type(4)))float;
using u32x4=__attribute__((ext_vector_type(4)))unsigned;
constexpr int PITCH=512;
constexpr int NW=8,QBLK=32,QB=QBLK*NW,KVBLK=64;
__device__ __forceinline__ int crow(int r,int hi){return (r&3)+8*(r>>2)+4*hi;}
#define SBAR() __builtin_amdgcn_sched_barrier(0)
__device__ __forceinline__ void cmask(f32x16&p0,f32x16&p1,int jb,int qrel,int hi){
  const float NEG=-INFINITY; int kb=64*jb+4*hi;
  #pragma unroll
  for(int r=0;r<16;++r){int kv=kb+(r&3)+8*(r>>2); if(kv>qrel)p0[r]=NEG; if(kv+32>qrel)p1[r]=NEG;}
}
constexpr int NSLOT=3, SLOTB=8192;
constexpr int LDS_K=0, LDS_V=NSLOT*SLOTB, LDS_WS=2*NSLOT*SLOTB, LDS_BIAS=LDS_WS+NW*64*4, LDS_OST=LDS_BIAS+NW*3*256, LDS_MISC=LDS_OST+2*NW*4096, LDS_BYTES=LDS_MISC+64;
__device__ __forceinline__ void glds16(const void*sbase,unsigned voff,unsigned lds_dst){unsigned keep;
  asm volatile("s_mov_b32 %0, m0\n\ts_mov_b32 m0, %3\n\ts_nop 4\n\tglobal_load_lds_dwordx4 %1, %2\n\ts_mov_b32 m0, %0":"=&s"(keep):"v"(voff),"s"(sbase),"s"(lds_dst):"memory");}
__device__ __forceinline__ void glds4(const void*sbase,unsigned voff,unsigned lds_dst){unsigned keep;
  asm volatile("s_mov_b32 %0, m0\n\ts_mov_b32 m0, %3\n\ts_nop 4\n\tglobal_load_lds_dword %1, %2\n\ts_mov_b32 m0, %0":"=&s"(keep):"v"(voff),"s"(sbase),"s"(lds_dst):"memory");}
__device__ __forceinline__ float max3f(float a,float b,float c){float r;asm("v_max3_f32 %0, %1, %2, %3":"=v"(r):"v"(a),"v"(b),"v"(c));return r;}
__device__ __forceinline__ float max2f(float a,float b){float r;asm("v_max_f32_e32 %0, %1, %2":"=v"(r):"v"(a),"v"(b));return r;}
__device__ __forceinline__ float fadd_s(float a,float b){float r;asm("v_add_f32_e32 %0, %1, %2":"=v"(r):"v"(a),"v"(b));return r;}
__device__ __forceinline__ float fsub_s(float a,float b){float r;asm("v_sub_f32_e32 %0, %1, %2":"=v"(r):"v"(a),"v"(b));return r;}
typedef float f32x2_t __attribute__((ext_vector_type(2))); typedef __bf16 bf16x2_t __attribute__((ext_vector_type(2)));
__device__ __forceinline__ unsigned cvtpk_s(float lo,float hi){f32x2_t v={lo,hi};bf16x2_t b=__builtin_convertvector(v,bf16x2_t);return __builtin_bit_cast(unsigned,b);}
#define WAIT_BAR(N) asm volatile("s_waitcnt vmcnt(" #N ") lgkmcnt(0)\n\ts_barrier":::"memory")
typedef LAS const char* lds_cptr;
typedef short v4i16_t __attribute__((ext_vector_type(4)));
__device__ __forceinline__ void qkt(f32x16&p0,f32x16&p1,lds_cptr Kslot,const bf16x8*qr,int r32,int hi){
  const lds_cptr kb=Kslot+hi*1024+r32*16;
  #pragma unroll
  for(int d0=0;d0<4;++d0){
    const bf16x8 b0=*(const LAS bf16x8*)(kb+d0*2048);
    const bf16x8 b1=*(const LAS bf16x8*)(kb+d0*2048+512);
    p0=__builtin_amdgcn_mfma_f32_32x32x16_bf16(b0,qr[d0],p0,0,0,0);p1=__builtin_amdgcn_mfma_f32_32x32x16_bf16(b1,qr[d0],p1,0,0,0);}
}
__device__ __forceinline__ void kload8(bf16x8*kf,lds_cptr kp){
  kf[0]=*(const LAS bf16x8*)(kp);      kf[1]=*(const LAS bf16x8*)(kp+512);
  kf[2]=*(const LAS bf16x8*)(kp+2048); kf[3]=*(const LAS bf16x8*)(kp+2560);
  kf[4]=*(const LAS bf16x8*)(kp+4096); kf[5]=*(const LAS bf16x8*)(kp+4608);
  kf[6]=*(const LAS bf16x8*)(kp+6144); kf[7]=*(const LAS bf16x8*)(kp+6656);
}
__device__ __forceinline__ void kload2(bf16x8*kf,lds_cptr kp,int j){ kf[2*j]=*(const LAS bf16x8*)(kp+j*2048); kf[2*j+1]=*(const LAS bf16x8*)(kp+j*2048+512); }
__device__ __forceinline__ s16x4 vtr(lds_cptr p){ return __builtin_bit_cast(s16x4,__builtin_amdgcn_ds_read_tr16_b64_v4i16((LAS v4i16_t*)p)); }
__device__ __forceinline__ float rowmax(const f32x16&p0,const f32x16&p1){
  float a=max3f(p0[0],p0[1],p1[0]),b=max3f(p0[2],p0[3],p1[1]);a=max3f(a,p1[2],p1[3]);
  #pragma unroll
  for(int r=4;r<16;r+=4){a=max3f(a,p0[r],p0[r+1]);b=max3f(b,p0[r+2],p0[r+3]);a=max3f(a,p1[r],p1[r+1]);b=max3f(b,p1[r+2],p1[r+3]);}
  const float m=max2f(a,b);
  auto rr=__builtin_amdgcn_permlane32_swap(__float_as_uint(m),__float_as_uint(m),false,false);
  return max2f(__uint_as_float(rr[0]),__uint_as_float(rr[1]));
}
__device__ __forceinline__ void pv(f32x16*o,int vb,bf16x8 pa0,bf16x8 pa1,bf16x8 pa2,bf16x8 pa3){
  #pragma unroll
  for(int d0=0;d0<2;++d0){s16x4 lo[4],hi[4];
    #pragma unroll
    for(int ks=0;ks<4;++ks){
      asm volatile("ds_read_b64_tr_b16 %0,%1 offset:%c2":"=&v"(lo[ks]):"v"(vb),"i"(d0*4096+ks*1024):"memory");
      asm volatile("ds_read_b64_tr_b16 %0,%1 offset:%c2":"=&v"(hi[ks]):"v"(vb),"i"(d0*4096+ks*1024+512):"memory");}
    asm volatile("s_waitcnt lgkmcnt(0)":::"memory");SBAR();
    #define PK(k) (bf16x8){lo[k][0],lo[k][1],lo[k][2],lo[k][3],hi[k][0],hi[k][1],hi[k][2],hi[k][3]}
    o[d0]=__builtin_amdgcn_mfma_f32_32x32x16_bf16(pa0,PK(0),o[d0],0,0,0);
    o[d0]=__builtin_amdgcn_mfma_f32_32x32x16_bf16(pa1,PK(1),o[d0],0,0,0);
    o[d0]=__builtin_amdgcn_mfma_f32_32x32x16_bf16(pa2,PK(2),o[d0],0,0,0);
    o[d0]=__builtin_amdgcn_mfma_f32_32x32x16_bf16(pa3,PK(3),o[d0],0,0,0);
    #undef PK
  }
}
template<int THRL,int EPI,int STAGE> __device__ __forceinline__ void fast_pass(const bf16_t*Qrows,const bf16_t*Kh,const bf16_t*Vh,const float*kbias,int qb,LAS char*shm,float f,int tid){
  constexpr int stage=STAGE;
  const int lane=tid&63,r32=lane&31,hi=lane>>5; const int wid=__builtin_amdgcn_readfirstlane(tid>>6);
  const int q0=qb*QB;
  const bf16_t*Qw=Qrows+(long)(wid*QBLK)*PITCH;
  const unsigned lds0=(unsigned)(uintptr_t)shm;
  LAS float*wsf=(LAS float*)(shm+LDS_WS)+wid*64;
  const LAS float*bias0=(const LAS float*)(shm+LDS_BIAS+wid*768);
  const unsigned koff=(unsigned)(lane*PITCH+wid*8)*2u;
  const unsigned voff=(unsigned)((16*(wid&3)+(lane>>2))*PITCH+(wid>>2)*32+(lane&3)*8)*2u;
  const unsigned boff=(unsigned)lane*4u;
  const unsigned kdst=lds0+LDS_K+wid*1024, vdst=lds0+LDS_V+wid*1024, bdst=lds0+LDS_BIAS+wid*768;
  #define DMA_K(t,slot) glds16(Kh+(long)(t)*KVBLK*PITCH,koff,(unsigned)__builtin_amdgcn_readfirstlane(kdst+(slot)))
  #define DMA_V(t,slot) glds16(Vh+(long)(t)*KVBLK*PITCH,voff,(unsigned)__builtin_amdgcn_readfirstlane(vdst+(slot)))
  #define DMA_B(t,slot) glds4(kbias+(t)*KVBLK,boff,(unsigned)__builtin_amdgcn_readfirstlane(bdst+((slot)>>5)))
  const int vb0=(int)(lds0+LDS_V)+((lane>>4)&1)*32+(lane&3)*8+(4*hi+((lane&15)>>2))*64;
  const lds_cptr shm3=(lds_cptr)shm; bf16x8 kf[8];
  const lds_cptr kp0=shm3+LDS_K+hi*1024+r32*16; const lds_cptr vp0=shm3+LDS_V+((lane>>4)&1)*32+(lane&3)*8+(4*hi+((lane&15)>>2))*64;
  const int NT=(q0+QB)/KVBLK;
  DMA_K(0,0);DMA_V(0,0);DMA_K(1,SLOTB);DMA_B(0,0);DMA_B(1,SLOTB);
  bf16x8 qr[4];
  #pragma unroll
  for(int d0=0;d0<4;++d0)qr[d0]=*reinterpret_cast<const bf16x8*>(&Qw[(long)r32*PITCH+d0*16+hi*8]);
  float mhat=0.f,l_reg=0.f;f32x16 o[2];o[0]=f32x16{};o[1]=f32x16{};
  const int qrel=wid*QBLK+r32;
  #define CMASK(P0,P1,t) do{int jb_=(t)-(NT-4); if(jb_>=0)cmask(P0,P1,jb_,qrel,hi);}while(0)
  #define NMB(nm0,nm1) do{ const LAS float* bs_=bias0+(sl_cur>>7); const float nmh_=-mhat; \
    _Pragma("unroll") for(int gq=0;gq<4;++gq){ const f32x4 c0_=*(const LAS f32x4*)(bs_+8*gq+4*hi), c1_=*(const LAS f32x4*)(bs_+32+8*gq+4*hi); \
      _Pragma("unroll") for(int j=0;j<4;++j){ nm0[4*gq+j]=nmh_-c0_[j]; nm1[4*gq+j]=nmh_-c1_[j]; } } }while(0)
  bool resc=false;
  #define START(P0,P1) do{ const float rm=rowmax(P0,P1); resc=false; \
    { const float dl=rm; mhat=fadd_s(mhat,dl); \
      _Pragma("unroll") for(int r=0;r<16;++r){P0[r]=fsub_s(P0[r],dl);P1[r]=fsub_s(P1[r],dl);} } \
    _Pragma("unroll") for(int r=0;r<16;++r)P0[r]=__builtin_amdgcn_exp2f(P0[r]); }while(0)
  #define RESC() do{ if(resc){ asm volatile("s_waitcnt lgkmcnt(0)":::"memory"); \
      _Pragma("unroll") for(int d_=0;d_<2;++d_) _Pragma("unroll") for(int r=0;r<16;++r)o[d_][r]*=wsf[crow(r,hi)]; } }while(0)
  f32x16 pA0,pA1,pB0,pB1;
  int sl_prev=0,sl_cur=0,sl_next=SLOTB;
  #define ROT() do{sl_prev=sl_cur;sl_cur=sl_next;sl_next=(sl_next==(NSLOT-1)*SLOTB)?0:sl_next+SLOTB;}while(0)
  DMA_K(2,2*SLOTB);
  WAIT_BAR(3);
  NMB(pA0,pA1);
  qkt(pA0,pA1,shm3+LDS_K,qr,r32,hi);asm volatile("s_nop 15\n\ts_nop 7":"+v"(pA0),"+v"(pA1));CMASK(pA0,pA1,0);
  START(pA0,pA1);
  _Pragma("unroll") for(int r=0;r<16;++r)pA1[r]=__builtin_amdgcn_exp2f(pA1[r]);
  WAIT_BAR(0);
  DMA_K(3,0);DMA_V(1,SLOTB);DMA_B(2,2*SLOTB);
  ROT();
  kload8(kf,kp0+sl_cur);
  WAIT_BAR(3);
  s16x4 vlo[8],vhi[8]; u32x4 pw0,pw1,pw2,pw3;
  #define PKW(P,B) cvtpk_s(P[B],P[B+1])
  #define PAF(k) __builtin_bit_cast(bf16x8,pw##k)
  #define VFR(i) (bf16x8){vlo[i][0],vlo[i][1],vlo[i][2],vlo[i][3],vhi[i][0],vhi[i][1],vhi[i][2],vhi[i][3]}
  #define PIN(x) asm volatile("":"+v"(x))
  #define MX3(a,b,c) __builtin_fmaxf(__builtin_fmaxf((a),(b)),(c))
  #define GAPA(MF,A0,A1,A2,A3,W0,W1,PW) do{ MF; sacc+=A0; sacc+=A1; sacc+=A2; sacc+=A3; PIN(sacc); W0; W1; PIN(PW); SBAR(); }while(0)
  #define EX(v) __builtin_amdgcn_exp2f(v)
  #define GAPB(MF,X,B) do{ MF; X[B]=EX(X[B]); X[B+1]=EX(X[B+1]); X[B+2]=EX(X[B+2]); X[B+3]=EX(X[B+3]); PIN(X); SBAR(); }while(0)
  #define VRD(i) do{ vlo[i]=vtr(vp_+(((i)>>2)*4096+((i)&3)*1024)); vhi[i]=vtr(vp_+(((i)>>2)*4096+((i)&3)*1024+512)); }while(0)
  #define KRD(G,j) do{ if(G){ kload2(kf,kp0+sl_next,j); SBAR(); } }while(0)
  #define STEP(C0,C1,P0,P1,t,GK,GV,GL,GB) do{ NMB(C0,C1); SBAR(); \
    const lds_cptr vp_=vp0+sl_prev; \
    VRD(0); SBAR(); float sacc=(P0[0]+P0[1]); \
    GAPA(C0=__builtin_amdgcn_mfma_f32_32x32x16_bf16(kf[0],qr[0],C0,0,0,0), P0[2],P0[3],P0[4],P0[5],     pw0[0]=PKW(P0,0), pw0[1]=PKW(P0,2), pw0); \
    VRD(4); SBAR(); GAPA(C1=__builtin_amdgcn_mfma_f32_32x32x16_bf16(kf[1],qr[0],C1,0,0,0), P0[6],P0[7],P0[8],P0[9],     pw0[2]=PKW(P0,4), pw0[3]=PKW(P0,6), pw0); \
    VRD(1); SBAR(); GAPA(C0=__builtin_amdgcn_mfma_f32_32x32x16_bf16(kf[2],qr[1],C0,0,0,0),   P0[10],P0[11],P0[12],P0[13], pw1[0]=PKW(P0,8), pw1[1]=PKW(P0,10), pw1); \
    VRD(5); SBAR(); GAPA(C1=__builtin_amdgcn_mfma_f32_32x32x16_bf16(kf[3],qr[1],C1,0,0,0),   P0[14],P0[15],P1[0],P1[1],   pw1[2]=PKW(P0,12),pw1[3]=PKW(P0,14), pw1); \
    VRD(2); SBAR(); GAPA(C0=__builtin_amdgcn_mfma_f32_32x32x16_bf16(kf[4],qr[2],C0,0,0,0),   P1[2],P1[3],P1[4],P1[5],     pw2[0]=PKW(P1,0), pw2[1]=PKW(P1,2), pw2); \
    VRD(6); SBAR(); GAPA(C1=__builtin_amdgcn_mfma_f32_32x32x16_bf16(kf[5],qr[2],C1,0,0,0),   P1[6],P1[7],P1[8],P1[9],     pw2[2]=PKW(P1,4), pw2[3]=PKW(P1,6), pw2); \
    VRD(3); SBAR(); GAPA(C0=__builtin_amdgcn_mfma_f32_32x32x16_bf16(kf[6],qr[3],C0,0,0,0),   P1[10],P1[11],P1[12],P1[13], pw3[0]=PKW(P1,8), pw3[1]=PKW(P1,10), pw3); \
    VRD(7); SBAR(); GAPA(C1=__builtin_amdgcn_mfma_f32_32x32x16_bf16(kf[7],qr[3],C1,0,0,0),   P1[14],P1[15],0.f,0.f,       pw3[2]=PKW(P1,12),pw3[3]=PKW(P1,14), pw3); \
    l_reg+=sacc; \
    if(GK){DMA_K((t)+3,sl_cur);} if(GV){DMA_V((t)+1,sl_next);} if(GB){DMA_B((t)+2,sl_prev);} \
    CMASK(C0,C1,t); \
    { float a=MX3(C0[0],C0[1],C1[0]),b=MX3(C0[2],C0[3],C1[1]); a=MX3(a,C1[2],C1[3]); \
      _Pragma("unroll") for(int r=4;r<16;r+=4){a=MX3(a,C0[r],C0[r+1]);b=MX3(b,C0[r+2],C0[r+3]);a=MX3(a,C1[r],C1[r+1]);b=MX3(b,C1[r+2],C1[r+3]);} \
      float rm=__builtin_fmaxf(a,b); { auto rr=__builtin_amdgcn_permlane32_swap(__float_as_uint(rm),__float_as_uint(rm),false,false); rm=__builtin_fmaxf(__uint_as_float(rr[0]),__uint_as_float(rr[1])); } \
      resc=false; \
      if(__builtin_expect(__any(rm>(float)THRL),0)){ const float dl=__builtin_fmaxf(rm,0.f); mhat+=dl; \
        _Pragma("unroll") for(int r=0;r<16;++r){C0[r]-=dl;C1[r]-=dl;} \
        const float f_=__builtin_amdgcn_exp2f(-dl); l_reg*=f_; if(hi==0)wsf[r32]=f_; resc=true; } } \
    SBAR(); \
    GAPB(o[0]=__builtin_amdgcn_mfma_f32_32x32x16_bf16(PAF(0),VFR(0),o[0],0,0,0), C0,0); \
    GAPB(o[1]=__builtin_amdgcn_mfma_f32_32x32x16_bf16(PAF(0),VFR(4),o[1],0,0,0), C0,4); \
    KRD(GL,0); GAPB(o[0]=__builtin_amdgcn_mfma_f32_32x32x16_bf16(PAF(1),VFR(1),o[0],0,0,0), C0,8); \
    KRD(GL,1); GAPB(o[1]=__builtin_amdgcn_mfma_f32_32x32x16_bf16(PAF(1),VFR(5),o[1],0,0,0), C0,12); \
    KRD(GL,2); GAPB(o[0]=__builtin_amdgcn_mfma_f32_32x32x16_bf16(PAF(2),VFR(2),o[0],0,0,0), C1,0); \
    KRD(GL,3); GAPB(o[1]=__builtin_amdgcn_mfma_f32_32x32x16_bf16(PAF(2),VFR(6),o[1],0,0,0), C1,4); \
    GAPB(o[0]=__builtin_amdgcn_mfma_f32_32x32x16_bf16(PAF(3),VFR(3),o[0],0,0,0), C1,8); \
    GAPB(o[1]=__builtin_amdgcn_mfma_f32_32x32x16_bf16(PAF(3),VFR(7),o[1],0,0,0), C1,12); \
    }while(0)
  int t=1;
  #undef CMASK
  #define CMASK(P0,P1,t) do{}while(0)
  for(;t+5<NT;t+=2){
    STEP(pB0,pB1,pA0,pA1,t,true,true,true,true);     WAIT_BAR(3); RESC(); ROT();
    STEP(pA0,pA1,pB0,pB1,t+1,true,true,true,true);   WAIT_BAR(3); RESC(); ROT();
  }
  #undef CMASK
  #define CMASK(P0,P1,t) do{int jb_=(t)-(NT-4); if(jb_>=0)cmask(P0,P1,jb_,qrel,hi);}while(0)
  #define ENDW(tt) do{ if((tt)+3<NT){WAIT_BAR(3);} else if((tt)+2<NT){WAIT_BAR(2);} else {WAIT_BAR(0);} }while(0)
  for(;t+1<NT;t+=2){
    STEP(pB0,pB1,pA0,pA1,t,(t+3<NT),(t+1<NT),(t+1<NT),(t+2<NT));       ENDW(t);   RESC(); ROT();
    STEP(pA0,pA1,pB0,pB1,t+1,(t+4<NT),(t+2<NT),(t+2<NT),(t+3<NT));     ENDW(t+1); RESC(); ROT();
  }
  STEP(pB0,pB1,pA0,pA1,NT-1,false,false,false,false); RESC();
  { float sacc=pB0[0]+pB0[1]; _Pragma("unroll") for(int r=2;r<16;++r)sacc+=pB0[r]; _Pragma("unroll") for(int r=0;r<16;++r)sacc+=pB1[r]; l_reg+=sacc;
    pw0=(u32x4){PKW(pB0,0),PKW(pB0,2),PKW(pB0,4),PKW(pB0,6)};pw1=(u32x4){PKW(pB0,8),PKW(pB0,10),PKW(pB0,12),PKW(pB0,14)};pw2=(u32x4){PKW(pB1,0),PKW(pB1,2),PKW(pB1,4),PKW(pB1,6)};pw3=(u32x4){PKW(pB1,8),PKW(pB1,10),PKW(pB1,12),PKW(pB1,14)};
    SBAR(); pv(o,vb0+sl_cur,PAF(0),PAF(1),PAF(2),PAF(3)); }
  #undef PKW
  #undef PAF
  #undef VFR
  #undef PIN
  #undef MX3
  #undef GAPA
  #undef GAPB
  #undef EX
  #undef VRD
  #undef KRD
  #undef STEP
  #undef ENDW
  #undef NMB
  {auto rr=__builtin_amdgcn_permlane32_swap(__float_as_uint(l_reg),__float_as_uint(l_reg),false,false);l_reg=__uint_as_float(rr[0])+__uint_as_float(rr[1]);}
  if(hi==0)wsf[32+r32]=l_reg;asm volatile("s_waitcnt lgkmcnt(0)":::"memory");
  float rli[16];
  #pragma unroll
  for(int r=0;r<16;++r)rli[r]=__builtin_amdgcn_rcpf(wsf[32+crow(r,hi)]);
  { LAS bf16_t*stg=(LAS bf16_t*)(shm+LDS_OST+(stage*NW+wid)*4096);
    #pragma unroll
    for(int r=0;r<16;++r){const int orow=crow(r,hi);
      #pragma unroll
      for(int d0=0;d0<2;++d0){ const int idx=orow*64+d0*32+r32; float val=o[d0][r]*rli[r];
        if(EPI==1) val=__uint_as_float(((unsigned)stg[idx])<<16)-f*val;
        stg[idx]=(bf16_t)(cvtpk_s(val,0.f)&0xffffu); } } }
  asm volatile("s_waitcnt lgkmcnt(0)\n\ts_barrier":::"memory");
  #undef DMA_K
  #undef DMA_V
  #undef DMA_B
  #undef CMASK
  #undef START
  #undef RESC
  #undef ROT
}
#undef SBAR
#undef WAIT_BAR

__device__ __forceinline__ void fox_final(LAS char*shm,bf16_t*Qrows,int tid){
  const int lane=tid&63; const int wid=__builtin_amdgcn_readfirstlane(tid>>6);
  const LAS bf16_t*stg=(const LAS bf16_t*)(shm+LDS_OST+wid*4096); bf16_t*Ow=Qrows+(size_t)(wid*QBLK)*PITCH;
  #pragma unroll
  for(int i=0;i<4;++i){const int row=i*8+(lane>>3),ch=lane&7; const u32x4 v=*(const LAS u32x4*)(stg+row*64+ch*8); *(u32x4*)(Ow+(size_t)row*PITCH+ch*8)=v;}
}
__device__ __forceinline__ void diff_final(LAS char*shm,bf16_t*Qrows,float post,const float*gn,int tid){
  const int lane=tid&63; const int wid=__builtin_amdgcn_readfirstlane(tid>>6);
  const int row=lane>>1,hv=lane&1;
  const LAS bf16_t*stg=(const LAS bf16_t*)(shm+LDS_OST+(hv*NW+wid)*4096)+row*64;
  float v[64]; float ss=0.f;
  #pragma unroll
  for(int c=0;c<8;++c){ const u32x4 w=*(const LAS u32x4*)(stg+c*8);
    #pragma unroll
    for(int j=0;j<4;++j){ v[8*c+2*j]=__uint_as_float(w[j]<<16); v[8*c+2*j+1]=__uint_as_float(w[j]&0xffff0000u); ss+=v[8*c+2*j]*v[8*c+2*j]+v[8*c+2*j+1]*v[8*c+2*j+1]; } }
  ss+=__shfl_xor(ss,1);
  const float rr=post/sqrtf(ss*(1.f/128.f)+RMS_EPS);
  bf16_t*orow=Qrows+(size_t)(wid*QBLK+row)*PITCH+hv*64; const float*g=gn+hv*64;
  #pragma unroll
  for(int c=0;c<8;++c){ const f32x4 g0=*(const f32x4*)(g+8*c), g1=*(const f32x4*)(g+8*c+4); u32x4 w;
    w[0]=cvtpk_s(v[8*c]*rr*g0[0],v[8*c+1]*rr*g0[1]); w[1]=cvtpk_s(v[8*c+2]*rr*g0[2],v[8*c+3]*rr*g0[3]); w[2]=cvtpk_s(v[8*c+4]*rr*g1[0],v[8*c+5]*rr*g1[1]); w[3]=cvtpk_s(v[8*c+6]*rr*g1[2],v[8*c+7]*rr*g1[3]);
    *(u32x4*)(orow+8*c)=w; }
}
#undef LAS
}

#define LAS __attribute__((address_space(3)))
typedef unsigned short bf16;
typedef unsigned v4u __attribute__((ext_vector_type(4)));
typedef float f32x4 __attribute__((ext_vector_type(4)));
constexpr int NWAVES = 8;
constexpr int RING_BYTES = 131072;
constexpr int LDSCTL_OFF = RING_BYTES;
constexpr int LDS_BYTES = 139264;
static_assert(att::ATT_LDS_BYTES <= RING_BYTES && af::LDS_BYTES <= RING_BYTES && att::L_B + 512 <= af::LDS_MISC, "attention scratch fits the ring region");

__device__ __forceinline__ unsigned f2bf(float f) { unsigned u = __builtin_bit_cast(unsigned, f); return (u + 0x7fffu + ((u >> 16) & 1u)) >> 16; }
__device__ __forceinline__ unsigned pk2(float lo, float hi) { return f2bf(lo) | (f2bf(hi) << 16); }
__device__ __forceinline__ float wave_sum(float v) {
#pragma unroll
    for (int o = 1; o < 64; o <<= 1) v += __shfl_xor(v, o);
    return v;
}
__device__ __forceinline__ void transpose_item(const float* W, int ldw, int K, bf16* WT, LAS float* scr, int kb, int lane) {
    const int k0 = 64 * kb;
    float t[32];
#pragma unroll
    for (int i = 0; i < 32; ++i) { const int kk = 2 * i + (lane >> 5); t[i] = W[(size_t)(k0 + kk) * ldw + (lane & 31)]; }
    asm volatile("" ::: "memory");
#pragma unroll
    for (int i = 0; i < 32; ++i) { const int kk = 2 * i + (lane >> 5); scr[kk * 33 + (lane & 31)] = t[i]; }
    asm volatile("s_waitcnt lgkmcnt(0)" ::: "memory");
    const int c = lane & 7;
#pragma unroll
    for (int j = 0; j < 4; ++j) { const int n = (lane >> 3) + 8 * j; const LAS float* s = scr + (8 * c) * 33 + n;
        v4u o; o.x = pk2(s[0 * 33], s[1 * 33]); o.y = pk2(s[2 * 33], s[3 * 33]); o.z = pk2(s[4 * 33], s[5 * 33]); o.w = pk2(s[6 * 33], s[7 * 33]);
        *(v4u*)(WT + (size_t)n * K + k0 + 8 * c) = o; }
    asm volatile("s_waitcnt lgkmcnt(0)" ::: "memory");
}
__device__ __forceinline__ int src_col_qkv(int n) { const int s = n >> 9; const int c = s == 0 ? 0 : s == 1 ? 2048 : s == 2 ? 4104 : s == 3 ? 512 : s == 4 ? 1024 : s == 5 ? 2560 : s == 6 ? 3072 : s == 7 ? 4616 : 5128; return c + (n & 511); }
__device__ __forceinline__ int src_col_zg(int n) { if (n >= 1536) return 6152 + (n - 1536); const int s = n >> 9; return (s == 0 ? 1536 : s == 1 ? 3592 : 5640) + (n & 511); }

#define XB_TMO      128
#define XB_XCNT(j)  (256  + 64 * (j))
#define XB_XSUB(j)  (1280 + 64 * (j))
#define XB_XGEN(j)  (2304 + 64 * (j))
#define XB_TOP      3328
#define XB_TOPGEN   3392
#define XCD_BAR_WORDS 3456
#define XB_SPIN_CAP (1u << 24)

__device__ __forceinline__ unsigned xb_ld(unsigned* p)              { return __hip_atomic_load(p, __ATOMIC_RELAXED, __HIP_MEMORY_SCOPE_AGENT); }
__device__ __forceinline__ unsigned xb_add(unsigned* p, unsigned v) { return __hip_atomic_fetch_add(p, v, __ATOMIC_RELAXED, __HIP_MEMORY_SCOPE_AGENT); }
__device__ __forceinline__ unsigned xb_xcc_id() { return (unsigned)__builtin_amdgcn_s_getreg((3 << 11) | 20) & 0xFu; }
#define XB_SPIN(cond, bar) do { unsigned _sp = 0; while (cond) { __builtin_amdgcn_s_sleep(1); \
    if ((++_sp & 255u) == 0u) { if (xb_ld(&(bar)[XB_TMO])) break; if (_sp > XB_SPIN_CAP) { atomicAdd(&(bar)[XB_TMO], 1u); break; } } } } while (0)

struct XcdBarrier {
    unsigned* bar; unsigned x;
    volatile LAS unsigned* st;
};

__device__ __forceinline__ XcdBarrier xcd_barrier_post(unsigned* bar, volatile LAS unsigned* st) {
    XcdBarrier b; b.bar = bar; b.x = xb_xcc_id(); b.st = st;
    if (threadIdx.x == 0) (void)xb_add(&bar[XB_XCNT(b.x)], 1u);
    return b;
}
__device__ __forceinline__ void xcd_barrier_complete(unsigned* bar, unsigned x, unsigned& nloc, unsigned& nx) {
    const unsigned G = gridDim.x * gridDim.y * gridDim.z;
    unsigned sum, cnt, mine, sp = 0u;
    for (;;) {
        sum = 0u; cnt = 0u; mine = 0u;
#pragma unroll
        for (unsigned j = 0; j < 16; ++j) { const unsigned c = xb_ld(&bar[XB_XCNT(j)]); sum += c; cnt += (c > 0u) ? 1u : 0u; mine = (j == x) ? c : mine; }
        if (sum == G) break;
        __builtin_amdgcn_s_sleep(1);
        if ((++sp & 255u) == 0u) { if (xb_ld(&bar[XB_TMO])) break; if (sp > XB_SPIN_CAP) { atomicAdd(&bar[XB_TMO], 1u); break; } }
    }
    nloc = mine > 0u ? mine : 1u; nx = cnt > 0u ? cnt : 1u;
}

__device__ __forceinline__ void xcd_barrier(const XcdBarrier& b) {
    asm volatile("s_waitcnt vmcnt(0)" ::: "memory");
    __syncthreads();
    if (threadIdx.x == 0) {
        unsigned* bar = b.bar;
        __builtin_amdgcn_s_waitcnt(0);
        unsigned nloc = b.st[0], nx = b.st[1];
        if (nloc == 0u) { xcd_barrier_complete(bar, b.x, nloc, nx); b.st[0] = nloc; b.st[1] = nx; }
        const unsigned old = xb_add(&bar[XB_XSUB(b.x)], 1u);
        const unsigned gen = old / nloc;
        if (old + 1u == (gen + 1u) * nloc) {
            __builtin_amdgcn_fence(__ATOMIC_RELEASE, "agent");
            asm volatile("s_waitcnt vmcnt(0)" ::: "memory");
            const unsigned og = xb_add(&bar[XB_TOP], 1u);
            const unsigned tg = og / nx;
            if (og + 1u == (tg + 1u) * nx) xb_add(&bar[XB_TOPGEN], 1u);
            else XB_SPIN(xb_ld(&bar[XB_TOPGEN]) == tg, bar);
            __builtin_amdgcn_fence(__ATOMIC_ACQUIRE, "agent");
            xb_add(&bar[XB_XGEN(b.x)], 1u);
            asm volatile("s_waitcnt vmcnt(0)" ::: "memory");
        } else {
            XB_SPIN(xb_ld(&bar[XB_XGEN(b.x)]) == gen, bar);
            __builtin_amdgcn_fence(__ATOMIC_ACQUIRE, "agent");
            asm volatile("s_waitcnt vmcnt(0)" ::: "memory");
        }
    }
    __syncthreads();
}

struct Args { const float* in[9]; float* out; unsigned char* ws; };
__device__ __forceinline__ void load_args(Args& A) {
    const __attribute__((address_space(4))) Args* ap_ = (const __attribute__((address_space(4))) Args*)__builtin_amdgcn_kernarg_segment_ptr(); asm volatile("" : "+s"(ap_));
#pragma unroll
    for (int i = 0; i < 9; ++i) A.in[i] = ap_->in[i];
    A.out = ap_->out; A.ws = ap_->ws;
}
#define ARGS_FRESH(A) Args A; load_args(A)

__device__ __forceinline__ void phase_weights(LAS unsigned char* lds) {
    int tid = threadIdx.x; asm volatile("" : "+v"(tid)); const int lane = tid & 63, wave = __builtin_amdgcn_readfirstlane(tid >> 6); (void)lane; (void)wave;
    ARGS_FRESH(A);
    LAS float* scr = (LAS float*)(lds + wave * 16384);
    const int gw = blockIdx.x * NWAVES + wave, NGW = gridDim.x * NWAVES;
    for (int i = gw * 64 + lane; i < 4 * SEQ; i += NGW * 64) ((float*)(A.ws + WS_ALIBI))[i] = -__builtin_amdgcn_exp2f(-2.f * (float)((i >> 12) + 1)) * LOG2E * (float)(i & (SEQ - 1));
    constexpr int I_IN = 16 * 144, I_B = 3 * 8 * 32, I_O = 16 * 32, I_LAYER = 2 * I_IN + I_B + I_O;
    for (int it = gw; it < NLAYER * I_LAYER; it += NGW) {
        const int l = it / I_LAYER; int r = it % I_LAYER;
        bf16* wl = (bf16*)(A.ws + WS_W + (size_t)l * W_LAYER);
        const float* w_in = A.in[2] + (size_t)l * DM * INW;
        if (r < I_IN) { const int kb = r / 144, n0 = (r % 144) * 32; transpose_item(w_in + src_col_qkv(n0), INW, 1024, (bf16*)((unsigned char*)wl + W_QKV) + (size_t)n0 * 1024, scr, kb, lane); continue; } r -= I_IN;
        if (r < I_IN) { const int kb = r / 144, n0 = (r % 144) * 32; transpose_item(w_in + src_col_zg(n0), INW, 1024, (bf16*)((unsigned char*)wl + W_ZG) + (size_t)n0 * 1024, scr, kb, lane); continue; } r -= I_IN;
        if (r < I_B) { const int nb = r / 256, rr = r % 256, kb = rr / 32, n0 = (rr % 32) * 32;
            transpose_item(A.in[6] + ((size_t)(l * 3 + nb) * 512) * 1024 + n0, 1024, 512, (bf16*)((unsigned char*)wl + W_B) + ((size_t)nb * 1024 + n0) * 512, scr, kb, lane); continue; } r -= I_B;
        { const int kb = r / 32, n0 = (r % 32) * 32; transpose_item(A.in[7] + (size_t)l * 1024 * 1024 + n0, 1024, 1024, (bf16*)((unsigned char*)wl + W_O) + (size_t)n0 * 1024, scr, kb, lane); }
    }
}

__device__ __forceinline__ void phase_norm(int l, bool first, LAS unsigned char* lds) {
    int tid = threadIdx.x; asm volatile("" : "+v"(tid)); const int lane = tid & 63, wave = __builtin_amdgcn_readfirstlane(tid >> 6); (void)lane; (void)wave;
    ARGS_FRESH(A); asm volatile("" : "+s"(l)); const float* xin = first ? A.in[0] : A.out;
    LAS float* wf = (LAS float*)lds;
    const float* w_in = A.in[2] + (size_t)l * DM * INW;
    for (int idx = tid; idx < 8192; idx += NWAVES * 64) { const int k = idx >> 3, h = idx & 7; wf[h * 1024 + k] = w_in[(size_t)k * INW + 3584 + h]; }
    __syncthreads();
    if (blockIdx.x == 0 && wave == 0) {
        const float* dl = A.in[4] + (size_t)l * 256;
        const float sa = wave_sum(dl[lane] * dl[64 + lane]), sb = wave_sum(dl[128 + lane] * dl[192 + lane]);
        const float lam_init = 0.8f - 0.6f * expf(-0.3f * (float)l);
        if (lane == 0) ((float*)(A.ws + WS_CTL))[CW_LAM + l] = expf(sa) - expf(sb) + lam_init;
    }
    const float* g = A.in[1] + (size_t)l * DM; const float* fb = A.in[3] + l * 8;
    bf16* XN = (bf16*)(A.ws + WS_XN); float* LOGF = (float*)(A.ws + WS_LOGF);
    f32x4 gv[4];
#pragma unroll
    for (int j = 0; j < 4; ++j) gv[j] = *(const f32x4*)(g + 4 * lane + 256 * j);
    f32x4 wr[8][4];
#pragma unroll
    for (int h = 0; h < 8; ++h)
#pragma unroll
        for (int j = 0; j < 4; ++j) wr[h][j] = *(const LAS f32x4*)(wf + h * 1024 + 4 * lane + 256 * j);
    const bool b0 = lane & 1, b1 = lane & 2, b2 = lane & 4;
    const int head = 4 * (lane & 1) + (lane & 2) + ((lane >> 2) & 1);
    const float fbv = fb[head];
    const int gw = blockIdx.x * NWAVES + wave, NGW = gridDim.x * NWAVES;
    auto load_row = [&](f32x4 (&d)[4], int m) { const f32x4* xr = (const f32x4*)(xin + (size_t)m * DM) + lane;
#pragma unroll
        for (int j = 0; j < 4; ++j) d[j] = xr[64 * j]; };
    auto do_row = [&](f32x4 (&v)[4], const int m) {
        float ss = 0.f;
#pragma unroll
        for (int j = 0; j < 4; ++j) ss += (v[j].x * v[j].x + v[j].y * v[j].y) + (v[j].z * v[j].z + v[j].w * v[j].w);
        const float rs = 1.f / sqrtf(wave_sum(ss) * (1.f / DM) + RMS_EPS);
        unsigned long long* o8 = (unsigned long long*)(XN + (size_t)m * DM) + lane;
        typedef float f32x2_n __attribute__((ext_vector_type(2)));
        f32x2_n f2[8];
#pragma unroll
        for (int h = 0; h < 8; ++h) f2[h] = (f32x2_n){0.f, 0.f};
#pragma unroll
        for (int j = 0; j < 4; ++j) { v[j] = v[j] * rs * gv[j];
            o8[64 * j] = (unsigned long long)pg8::cvt_pk_bf16(v[j].x, v[j].y) | ((unsigned long long)pg8::cvt_pk_bf16(v[j].z, v[j].w) << 32);
            const f32x2_n vlo = {v[j].x, v[j].y}, vhi = {v[j].z, v[j].w};
#pragma unroll
            for (int h = 0; h < 8; ++h) { const f32x4 w4 = wr[h][j]; f2[h] += vlo * (f32x2_n){w4.x, w4.y}; f2[h] += vhi * (f32x2_n){w4.z, w4.w}; } }
        float f[8];
#pragma unroll
        for (int h = 0; h < 8; ++h) f[h] = f2[h][0] + f2[h][1];
        float g4[4], g2[2];
#pragma unroll
        for (int i = 0; i < 4; ++i) { const float keep = b0 ? f[4 + i] : f[i], send = b0 ? f[i] : f[4 + i]; g4[i] = keep + __shfl_xor(send, 1); }
#pragma unroll
        for (int i = 0; i < 2; ++i) { const float keep = b1 ? g4[2 + i] : g4[i], send = b1 ? g4[i] : g4[2 + i]; g2[i] = keep + __shfl_xor(send, 2); }
        float fs; { const float keep = b2 ? g2[1] : g2[0], send = b2 ? g2[0] : g2[1]; fs = keep + __shfl_xor(send, 4); }
        fs += __shfl_xor(fs, 8); fs += __shfl_xor(fs, 16); fs += __shfl_xor(fs, 32);
        if (lane < 8) { const float xv = fs + fbv;
            const float ls2 = fminf(xv, 0.f) * LOG2E - __builtin_amdgcn_logf(1.f + __builtin_amdgcn_exp2f(-fabsf(xv) * LOG2E));
            LOGF[((size_t)(m / SEQ) * 8 + head) * SEQ + (m % SEQ)] = ls2; } };
    f32x4 va[4], vb[4];
    if (gw < MTOK) load_row(va, gw);
    if (gw + NGW < MTOK) load_row(vb, gw + NGW);
    for (int m = gw; m < MTOK; m += 2 * NGW) {
        { f32x4 v[4];
#pragma unroll
          for (int j = 0; j < 4; ++j) v[j] = va[j];
          if (m + 2 * NGW < MTOK) load_row(va, m + 2 * NGW);
          asm volatile("" ::: "memory");
          do_row(v, m); }
        if (m + NGW >= MTOK) break;
        { f32x4 v[4];
#pragma unroll
          for (int j = 0; j < 4; ++j) v[j] = vb[j];
          if (m + 3 * NGW < MTOK) load_row(vb, m + 3 * NGW);
          asm volatile("" ::: "memory");
          do_row(v, m + NGW); }
    }
    __syncthreads();
}
__device__ __forceinline__ void phase_cumsum(LAS unsigned char* lds) {
    int tid = threadIdx.x; asm volatile("" : "+v"(tid)); const int lane = tid & 63, wave = __builtin_amdgcn_readfirstlane(tid >> 6);
    if (blockIdx.x >= 64) return;
    ARGS_FRESH(A);
    const int bh = blockIdx.x;
    volatile LAS float* wt = (volatile LAS float*)(lds + LDSCTL_OFF + 64);
    const float* src = (const float*)(A.ws + WS_LOGF) + (size_t)bh * SEQ + 512 * wave + 8 * lane; float* dst = (float*)(A.ws + WS_CL2) + (size_t)bh * SEQ + 512 * wave + 8 * lane;
    f32x4 v0 = ((const f32x4*)src)[0], v1 = ((const f32x4*)src)[1];
    v0.y += v0.x; v0.z += v0.y; v0.w += v0.z; v1.x += v0.w; v1.y += v1.x; v1.z += v1.y; v1.w += v1.z;
    const float tot = v1.w; float inc = tot;
#pragma unroll
    for (int o = 1; o < 64; o <<= 1) { const float t = __shfl_up(inc, o); if (lane >= o) inc += t; }
    if (lane == 63) wt[wave] = inc;
    __syncthreads();
    float run = inc - tot;
#pragma unroll
    for (int w = 0; w < NWAVES - 1; ++w) run += (w < wave) ? wt[w] : 0.f;
    v0 = v0 + run; v1 = v1 + run;
    ((f32x4*)dst)[0] = v0; ((f32x4*)dst)[1] = v1;
}
__device__ __forceinline__ void phase_final() {
    int tid = threadIdx.x; asm volatile("" : "+v"(tid)); const int lane = tid & 63, wave = __builtin_amdgcn_readfirstlane(tid >> 6); (void)lane; (void)wave;
    ARGS_FRESH(A);
    const float* g = A.in[8]; float* X = A.out;
    f32x4 gv[4];
#pragma unroll
    for (int j = 0; j < 4; ++j) gv[j] = *(const f32x4*)(g + 4 * lane + 256 * j);
    const int gw = blockIdx.x * NWAVES + wave, NGW = gridDim.x * NWAVES;
    auto load_row = [&](f32x4 (&d)[4], int m) { const f32x4* xr = (const f32x4*)(X + (size_t)m * DM) + lane;
#pragma unroll
        for (int j = 0; j < 4; ++j) d[j] = xr[64 * j]; };
    auto do_row = [&](const f32x4 (&v)[4], const int m) {
        f32x4* xr = (f32x4*)(X + (size_t)m * DM) + lane; float ss = 0.f;
#pragma unroll
        for (int j = 0; j < 4; ++j) ss += (v[j].x * v[j].x + v[j].y * v[j].y) + (v[j].z * v[j].z + v[j].w * v[j].w);
        const float rs = 1.f / sqrtf(wave_sum(ss) * (1.f / DM) + RMS_EPS);
#pragma unroll
        for (int j = 0; j < 4; ++j) xr[64 * j] = v[j] * rs * gv[j]; };
    f32x4 va[4], vb[4];
    if (gw < MTOK) load_row(va, gw);
    if (gw + NGW < MTOK) load_row(vb, gw + NGW);
    for (int m = gw; m < MTOK; m += 2 * NGW) {
        { f32x4 v[4];
#pragma unroll
          for (int j = 0; j < 4; ++j) v[j] = va[j];
          if (m + 2 * NGW < MTOK) load_row(va, m + 2 * NGW);
          asm volatile("" ::: "memory");
          do_row(v, m); }
        if (m + NGW >= MTOK) break;
        { f32x4 v[4];
#pragma unroll
          for (int j = 0; j < 4; ++j) v[j] = vb[j];
          if (m + 3 * NGW < MTOK) load_row(vb, m + 3 * NGW);
          asm volatile("" ::: "memory");
          do_row(v, m + NGW); }
    }
}
__device__ __forceinline__ void phase_attention(int l, LAS unsigned char* lds) {
    int tid = threadIdx.x; asm volatile("" : "+v"(tid)); const int lane = tid & 63, wave = __builtin_amdgcn_readfirstlane(tid >> 6); (void)lane; (void)wave;
    ARGS_FRESH(A); asm volatile("" : "+s"(l));
    unsigned* qhead = (unsigned*)(A.ws + WS_CTL) + CW_QUEUE + 64 * l;
    volatile LAS unsigned* misc = (volatile LAS unsigned*)(lds + LDSCTL_OFF + 128);
    bf16* QKV = (bf16*)(A.ws + WS_QKV); const size_t BUF = (size_t)MTOK * 512;
    const float lam = ((const float*)(A.ws + WS_CTL))[CW_LAM + l];
    const float post = 1.f - (0.8f - 0.6f * expf(-0.3f * (float)l));
    unsigned nxt = 0u; if (tid == 0) nxt = atomicAdd(qhead, 1u);
    for (;;) {
        if (tid == 0) misc[0] = nxt;
        __syncthreads();
        const int idx = (int)misc[0];
        __syncthreads();
        if (idx >= att::N_ATT_UNITS) break;
        if (tid == 0) nxt = atomicAdd(qhead, 1u);
        if (idx < att::N_DIFF_UNITS) {
            const int qb = 15 - idx / 32, bh = idx % 32, b = bh >> 2, h = bh & 3;
            att::diff_unit((LAS char*)lds, b, h, qb, QKV + 0 * BUF, QKV + 3 * BUF, QKV + 4 * BUF, lam, post, A.in[5] + (size_t)l * 512 + h * 128);
        } else if (idx < att::N_DIFF_UNITS + att::N_FOX_UNITS) {
            int tid2 = threadIdx.x; asm volatile("" : "+v"(tid2));
            const int j = idx - att::N_DIFF_UNITS, qb = 15 - j / 64, bh = j % 64, b = bh >> 3, h = bh & 7; const size_t t0 = (size_t)b * SEQ;
            bf16* Qr = QKV + 1 * BUF + (t0 + qb * 256) * 512 + h * 64;
            af::fast_pass<64, 0, 0>(Qr, QKV + 5 * BUF + t0 * 512 + h * 64, QKV + 6 * BUF + t0 * 512 + h * 64, (const float*)(A.ws + WS_CL2) + (size_t)bh * SEQ, qb, (LAS char*)lds, 0.f, tid2);
            af::fox_final((LAS char*)lds, Qr, tid2);
        } else {
            const int j = idx - att::N_DIFF_UNITS - att::N_FOX_UNITS, p = j >> 10, jj = j & 1023, bhp = jj >> 5, sub = jj & 31, b = bhp >> 2, hp = bhp & 3;
            const int nblk = 32 >> (2 * p), r = sub / nblk, blk = sub % nblk;
            att::dil_unit((LAS char*)lds, p, b, hp, r, blk, QKV + 2 * BUF, QKV + 7 * BUF, QKV + 8 * BUF, (bf16*)(A.ws + WS_DILO), (float*)(A.ws + WS_LSE));
        }
    }
}

#define GRID_SYNC() do { ARGS_FRESH(Ab); XcdBarrier bar_; bar_.bar = (unsigned*)(Ab.ws + WS_CTL) + CW_BAR; bar_.x = xb_xcc_id(); bar_.st = (volatile LAS unsigned*)(lds + LDSCTL_OFF) + 8; xcd_barrier(bar_); } while (0)
#define FRESH() ARGS_FRESH(A); unsigned char* ws = A.ws; int l = lyr; asm volatile("" : "+s"(l))
__device__ __forceinline__ void layer_phases(const int lyr, LAS unsigned char* lds, const int G, const int bx) {
        phase_cumsum(lds);
        { FRESH(); pg8::Gemm g{(const bf16*)(ws + WS_XN), (const bf16*)(ws + WS_W + (size_t)l * W_LAYER + W_QKV), MTOK, 4608, 1024}; pg8::StaticOrder S; S.init(MTOK, 4608, G, bx);
          pg8::EpiQKV E{(bf16*)(ws + WS_QKV)};

          pg8::gemm_phase<pg8::EpiQKV, pg8::StaticOrder, true, true>(lds, g, S, E);
          }
        GRID_SYNC();
        phase_attention(lyr, lds);
        GRID_SYNC();
        { FRESH(); pg8::Gemm g{(const bf16*)(ws + WS_XN), (const bf16*)(ws + WS_W + (size_t)l * W_LAYER + W_ZG), MTOK, 4608, 1024}; pg8::StaticOrder S; S.init(MTOK, 4608, G, bx);
          pg8::EpiZG E{(bf16*)(ws + WS_QKV), (bf16*)(ws + WS_GATES), (const bf16*)(ws + WS_DILO), (const float*)(ws + WS_LSE)};

          pg8::gemm_phase<pg8::EpiZG, pg8::StaticOrder, true, true>(lds, g, S, E);
          }
        GRID_SYNC();
        { FRESH(); pg8::StaticOrder S; S.init(MTOK, 1024, G, bx);
          pg8::Gemm g{(const bf16*)(ws + WS_QKV), (const bf16*)(ws + WS_W + (size_t)l * W_LAYER + W_B), MTOK, 1024, 512}; pg8::EpiBranch<0> E{(const bf16*)(ws + WS_GATES), (bf16*)(ws + WS_XN)};

          pg8::gemm_phase<pg8::EpiBranch<0>, pg8::StaticOrder, false, true>(lds, g, S, E);
          }
        { FRESH(); pg8::StaticOrder S; S.init(MTOK, 1024, G, bx);
          pg8::Gemm g{(const bf16*)(ws + WS_QKV + QKV_BUF), (const bf16*)(ws + WS_W + (size_t)l * W_LAYER + W_B + (size_t)1 * 1024 * 512 * 2), MTOK, 1024, 512}; pg8::EpiBranch<1> E{(const bf16*)(ws + WS_GATES), (bf16*)(ws + WS_XN)};

          pg8::gemm_phase<pg8::EpiBranch<1>, pg8::StaticOrder, false, true>(lds, g, S, E);
          }
        { FRESH(); pg8::StaticOrder S; S.init(MTOK, 1024, G, bx);
          pg8::Gemm g{(const bf16*)(ws + WS_QKV + 2 * QKV_BUF), (const bf16*)(ws + WS_W + (size_t)l * W_LAYER + W_B + (size_t)2 * 1024 * 512 * 2), MTOK, 1024, 512}; pg8::EpiBranch<2> E{(const bf16*)(ws + WS_GATES), (bf16*)(ws + WS_XN)};

          pg8::gemm_phase<pg8::EpiBranch<2>, pg8::StaticOrder, false, true>(lds, g, S, E);
          }
        GRID_SYNC();
        { FRESH(); pg8::Gemm g{(const bf16*)(ws + WS_XN), (const bf16*)(ws + WS_W + (size_t)l * W_LAYER + W_O), MTOK, 1024, 1024}; pg8::StaticOrder S; S.init(MTOK, 1024, G, bx);
          pg8::EpiOut E{l == 0 ? A.in[0] : A.out, A.out};

          pg8::gemm_phase<pg8::EpiOut, pg8::StaticOrder, false, true>(lds, g, S, E);
          }
        GRID_SYNC();
        if (lyr + 1 < NLAYER) { phase_norm(lyr + 1, false, lds); GRID_SYNC(); }
    }

__global__ void __launch_bounds__(NWAVES * 64, 2) fwd_megakernel(Args Akarg) {
    extern __shared__ __attribute__((aligned(16))) unsigned char lds_raw[];
    LAS unsigned char* lds = (LAS unsigned char*)lds_raw;
    const int G = gridDim.x, bx = blockIdx.x;
    if (threadIdx.x < 64) ((LAS unsigned*)(lds + LDSCTL_OFF))[threadIdx.x] = 0u;
    __syncthreads();
    { ARGS_FRESH(A); (void)xcd_barrier_post((unsigned*)(A.ws + WS_CTL) + CW_BAR, (volatile LAS unsigned*)(lds + LDSCTL_OFF) + 8); }
    phase_weights(lds);
    __syncthreads();
    phase_norm(0, true, lds);
    GRID_SYNC();
    layer_phases(0, lds, G, bx);
    layer_phases(1, lds, G, bx);
    phase_final();
}

extern "C" void kernel_launch(void* const* d_in, const int* in_sizes, int n_in, void* d_out, int out_size, void* d_ws, size_t ws_size, hipStream_t stream) {
    static int grid = 0;
    if (grid == 0) {
        if (n_in != 9 || in_sizes[0] != MTOK * DM || out_size != MTOK * DM || ws_size < WS_END) { fprintf(stderr, "kernel_launch: unexpected shapes (n_in %d, in0 %d, out %d, ws %zu); nothing launched\n", n_in, n_in > 0 ? in_sizes[0] : -1, out_size, ws_size); grid = -1; return; }
        int dev = 0, cus = 0, per_cu = 0;
        if (hipGetDevice(&dev) != hipSuccess || hipDeviceGetAttribute(&cus, hipDeviceAttributeMultiprocessorCount, dev) != hipSuccess) { grid = -1; return; }
        if (hipFuncSetAttribute((const void*)fwd_megakernel, hipFuncAttributeMaxDynamicSharedMemorySize, LDS_BYTES) != hipSuccess) { fprintf(stderr, "kernel_launch: hipFuncSetAttribute failed\n"); grid = -1; return; }
        if (hipOccupancyMaxActiveBlocksPerMultiprocessor(&per_cu, (const void*)fwd_megakernel, NWAVES * 64, LDS_BYTES) != hipSuccess || per_cu < 1) { fprintf(stderr, "kernel_launch: occupancy query says %d blocks per CU\n", per_cu); (void)hipGetLastError(); grid = -1; return; }
        grid = cus * per_cu;
    }
    if (grid < 0) return;
    if (hipMemsetAsync((char*)d_ws + WS_CTL, 0, CTL_ZERO_BYTES, stream) != hipSuccess) { fprintf(stderr, "kernel_launch: hipMemsetAsync failed\n"); return; }
    Args a{};
    for (int i = 0; i < 9; ++i) a.in[i] = (const float*)d_in[i];
    a.out = (float*)d_out; a.ws = (unsigned char*)d_ws;
    void* args[] = {&a};
    hipError_t e = hipLaunchCooperativeKernel((const void*)fwd_megakernel, dim3(grid), dim3(NWAVES * 64), args, LDS_BYTES, stream);
    if (e != hipSuccess) fprintf(stderr, "kernel_launch: cooperative launch failed: %s (grid %d)\n", hipGetErrorString(e), grid);
}
```

```cpp
#include <hip/hip_runtime.h>
#include <cstdio>
#include <cstdint>

constexpr int NB = 8, SEQ = 4096, DM = 1024, MTOK = NB * SEQ, NLAYER = 2, INW = 9224, BW = 512;
constexpr float LOG2E = 1.4426950408889634f;
constexpr float QSCALE = 0.125f * LOG2E;
constexpr float RMS_EPS = 1e-6f;
constexpr size_t MiB = 1u << 20;
constexpr size_t WS_CTL = 0;
constexpr size_t WS_ALIBI = 512 * 1024;
constexpr size_t WS_W = 1 * MiB, W_LAYER = 23 * MiB;
constexpr size_t W_QKV = 0, W_ZG = 9 * MiB, W_B = 18 * MiB, W_O = 21 * MiB;
constexpr size_t WS_LOGF = 47 * MiB, WS_CL2 = 48 * MiB, WS_LSE = 49 * MiB;
constexpr size_t WS_XN = 52 * MiB;
constexpr size_t WS_QKV = 116 * MiB, QKV_BUF = 32 * MiB;
constexpr size_t WS_GATES = WS_QKV + 3 * QKV_BUF;
constexpr size_t WS_DILO = 404 * MiB;
constexpr size_t WS_END = 500 * MiB;
constexpr size_t CTL_ZERO_BYTES = 65536;
constexpr int CW_BAR = 4096;
constexpr int CW_QUEUE = 64;
constexpr int CW_LAM = 256;
namespace pg8 {
#define PG8_LAS __attribute__((address_space(3)))
typedef unsigned short bf16_t;
typedef short bf16x8 __attribute__((ext_vector_type(8)));
typedef float f32x4 __attribute__((ext_vector_type(4)));
typedef unsigned u32x4 __attribute__((ext_vector_type(4)));
constexpr int BM = 256, BK = 64, HALF = 128, HTB = HALF * BK * 2  , STAGE_BYTES = 8 * HTB, NXCD = 8, WGM = 8;

__host__ __device__ __forceinline__ int lds_byte(int r, int c) { const int st = (r >> 4) * 2 + (c >> 5), rr = r & 15, cc = c & 31, ob = rr * 64 + cc * 2; return st * 1024 + (ob ^ (((ob >> 9) & 1) << 5)); }
__host__ __device__ __forceinline__ void stage_rc(int b, int& R, int& C) { const int st = b / 1024, sb = b % 1024, swz = sb ^ (((sb >> 9) & 1) << 5); R = (st >> 1) * 16 + swz / 64; C = (st & 1) * 32 + (swz % 64) / 2; }
__host__ __device__ __forceinline__ int perm32(int rho) { const int n = rho >> 4, i = rho & 15; return 8 * (i >> 2) + 4 * n + (i & 3); }

struct Unit { int pm, pn, z; };
struct Gemm { const bf16_t* A; const bf16_t* Bt; int M, N, K; };

struct StaticOrder {
    int nM, nN, nwg, G, c;
    __host__ __device__ void init(int M, int N, int G_, int c_) { nM = M / BM; nN = N / BM; nwg = nM * nN; G = G_; c = c_; }
    __host__ __device__ bool next(int i, Unit& u) const {
        const long L = (long)i * G + c; if (L >= nwg) return false;
        int wgid = (int)L; { const int q = nwg / NXCD, r = nwg % NXCD, xcd = wgid % NXCD, off = wgid / NXCD; wgid = (xcd < r ? xcd * (q + 1) : r * (q + 1) + (xcd - r) * q) + off; }
        const int nig = WGM * nN, gid = wgid / nig, fm = gid * WGM, gsz = (nM - fm) < WGM ? (nM - fm) : WGM;
        u.pm = fm + ((wgid % nig) % gsz); u.pn = (wgid % nig) / gsz; u.z = 0; return true;
    }
    __device__ __forceinline__ void a_ready(const Unit&) const {}
    __device__ __forceinline__ void done(const Unit&) const {}
};

struct BranchOrder {
    StaticOrder S; int cnt;
    __host__ __device__ void init(int M, int N, int G_, int c_) { S.init(M, N, G_, c_); Unit t; cnt = 0; while (S.next(cnt, t)) ++cnt; }
    __host__ __device__ bool next(int i, Unit& u) const { if (cnt == 0 || i >= 3 * cnt) return false; const int z = i / cnt; S.next(i - z * cnt, u); u.z = z; return true; }
    __device__ __forceinline__ void a_ready(const Unit&) const {}
    __device__ __forceinline__ void done(const Unit&) const {}
};

__device__ __forceinline__ unsigned cvt_pk_bf16(float lo, float hi) { typedef float f32x2_t __attribute__((ext_vector_type(2))); typedef __bf16 bf16x2_t __attribute__((ext_vector_type(2)));
    f32x2_t v = {lo, hi}; bf16x2_t b = __builtin_convertvector(v, bf16x2_t); return __builtin_bit_cast(unsigned, b); }
__device__ __forceinline__ void unpack8(const u32x4 w, float (&f)[8]) {
    f[0] = __uint_as_float(w.x << 16); f[1] = __uint_as_float(w.x & 0xffff0000u); f[2] = __uint_as_float(w.y << 16); f[3] = __uint_as_float(w.y & 0xffff0000u);
    f[4] = __uint_as_float(w.z << 16); f[5] = __uint_as_float(w.z & 0xffff0000u); f[6] = __uint_as_float(w.w << 16); f[7] = __uint_as_float(w.w & 0xffff0000u); }
__device__ __forceinline__ u32x4 pack8(const float (&f)[8]) { u32x4 w; w.x = cvt_pk_bf16(f[0], f[1]); w.y = cvt_pk_bf16(f[2], f[3]); w.z = cvt_pk_bf16(f[4], f[5]); w.w = cvt_pk_bf16(f[6], f[7]); return w; }
__device__ __forceinline__ float sigmoid_f(float x) { return __builtin_amdgcn_rcpf(1.f + __builtin_amdgcn_exp2f(-x * LOG2E)); }

struct EpiQKV {
    static constexpr bool PERM = true, AFTER_DRAIN = false;
    bf16_t* base;
    __device__ __forceinline__ void operator()(const f32x4 (&acc)[2][2][4][2], const Unit& u, int wr, int wc, int fr, int fq) const {
        const int row0 = u.pm * BM + wr * 64 + fr;
        bf16_t* b = base + (size_t)(u.pn >> 1) * ((size_t)MTOK * 512);
        const float sc = u.pn < 6 ? QSCALE : 1.f;
        const int col0 = (u.pn & 1) * 256 + wc * 32 + 8 * fq;
#pragma unroll
        for (int ai = 0; ai < 2; ++ai)
#pragma unroll
            for (int m = 0; m < 4; ++m) { bf16_t* rowp = b + (size_t)(row0 + ai * HALF + m * 16) * 512 + col0;
#pragma unroll
                for (int bj = 0; bj < 2; ++bj) { f32x4 v0 = acc[ai][bj][m][0], v1 = acc[ai][bj][m][1]; asm volatile("" : "+v"(v0), "+v"(v1)); v0 = v0 * sc; v1 = v1 * sc;
                    float f[8] = {v0[0], v0[1], v0[2], v0[3], v1[0], v1[1], v1[2], v1[3]};
                    *(u32x4*)(rowp + bj * HALF) = pack8(f); }
                asm volatile("" ::: "memory"); }
    }
};

struct EpiZG {
    static constexpr bool PERM = true, AFTER_DRAIN = false;
    bf16_t* qkv; bf16_t* gates; const bf16_t* dilo; const float* lse;
    __device__ __forceinline__ void operator()(const f32x4 (&acc)[2][2][4][2], const Unit& u, int wr, int wc, int fr, int fq) const {
        const int row0 = u.pm * BM + wr * 64 + fr;
        if (u.pn < 4) {
            bf16_t* yb = qkv + (size_t)(u.pn >> 1) * ((size_t)MTOK * 512);
            const unsigned off0 = (unsigned)row0 * 512u + (unsigned)((u.pn & 1) * 256 + wc * 32 + 8 * fq);
#pragma unroll
            for (int ai = 0; ai < 2; ++ai) {
                u32x4 ov[4][2];
#pragma unroll
                for (int m = 0; m < 4; ++m)
#pragma unroll
                    for (int bj = 0; bj < 2; ++bj) ov[m][bj] = __builtin_nontemporal_load((const u32x4*)(yb + off0 + (unsigned)((ai * HALF + m * 16) * 512 + bj * HALF)));
                asm volatile("" ::: "memory");
#pragma unroll
                for (int m = 0; m < 4; ++m) {
#pragma unroll
                    for (int bj = 0; bj < 2; ++bj) { const unsigned off = off0 + (unsigned)((ai * HALF + m * 16) * 512 + bj * HALF); float o[8];
                        unpack8(ov[m][bj], o);
                        const f32x4 z0 = acc[ai][bj][m][0], z1 = acc[ai][bj][m][1];
                        f32x4 e0 = z0 * (-LOG2E), e1 = z1 * (-LOG2E); asm volatile("" : "+v"(e0), "+v"(e1));
#pragma unroll
                        for (int i = 0; i < 4; ++i) { e0[i] = __builtin_amdgcn_exp2f(e0[i]); e1[i] = __builtin_amdgcn_exp2f(e1[i]); }
                        e0 = e0 + 1.f; e1 = e1 + 1.f; asm volatile("" : "+v"(e0), "+v"(e1));
#pragma unroll
                        for (int i = 0; i < 4; ++i) { e0[i] = __builtin_amdgcn_rcpf(e0[i]); e1[i] = __builtin_amdgcn_rcpf(e1[i]); }
                        const f32x4 o0 = {o[0], o[1], o[2], o[3]}, o1 = {o[4], o[5], o[6], o[7]};
                        const f32x4 y0 = (o0 * z0) * e0, y1 = (o1 * z1) * e1;
                        const float y[8] = {y0[0], y0[1], y0[2], y0[3], y1[0], y1[1], y1[2], y1[3]};
                        *(u32x4*)(yb + off) = pack8(y); }
                    asm volatile("" ::: "memory"); } }
        } else if (u.pn < 6) {
            bf16_t* yb = qkv + (size_t)2 * ((size_t)MTOK * 512);
            const unsigned off0 = (unsigned)row0 * 512u + (unsigned)((u.pn & 1) * 256 + wc * 32 + 8 * fq);
            const int hd0 = (u.pn & 1) * 4 + (wc >> 1);
#pragma unroll
            for (int ai = 0; ai < 2; ++ai)
#pragma unroll
                for (int m = 0; m < 4; ++m) {
                    u32x4 dv[2][3]; float lv[2][3]; const int rr = ai * HALF + m * 16;
#pragma unroll
                    for (int bj = 0; bj < 2; ++bj) { const unsigned off = off0 + (unsigned)(rr * 512 + bj * HALF);
#pragma unroll
                        for (int p = 0; p < 3; ++p) { dv[bj][p] = *(const u32x4*)(dilo + (size_t)p * ((size_t)MTOK * 512) + off); lv[bj][p] = lse[((size_t)p * MTOK + (size_t)(row0 + rr)) * 8 + hd0 + 2 * bj]; } }
                    asm volatile("" ::: "memory");
#pragma unroll
                    for (int bj = 0; bj < 2; ++bj) { const unsigned off = off0 + (unsigned)(rr * 512 + bj * HALF);
                        const float l0 = lv[bj][0], l1 = lv[bj][1], l2 = lv[bj][2]; const float mx = fmaxf(fmaxf(l0, l1), l2);
                        float w0 = __builtin_amdgcn_exp2f(l0 - mx), w1 = __builtin_amdgcn_exp2f(l1 - mx), w2 = __builtin_amdgcn_exp2f(l2 - mx);
                        const float inv = 1.f / (w0 + w1 + w2); w0 *= inv; w1 *= inv; w2 *= inv;
                        float a0[8], a1[8], a2[8]; unpack8(dv[bj][0], a0); unpack8(dv[bj][1], a1); unpack8(dv[bj][2], a2);
                        const f32x4 z0 = acc[ai][bj][m][0], z1 = acc[ai][bj][m][1];
                        f32x4 e0 = z0 * (-LOG2E), e1 = z1 * (-LOG2E); asm volatile("" : "+v"(e0), "+v"(e1));
#pragma unroll
                        for (int i = 0; i < 4; ++i) { e0[i] = __builtin_amdgcn_exp2f(e0[i]); e1[i] = __builtin_amdgcn_exp2f(e1[i]); }
                        e0 = e0 + 1.f; e1 = e1 + 1.f; asm volatile("" : "+v"(e0), "+v"(e1));
#pragma unroll
                        for (int i = 0; i < 4; ++i) { e0[i] = __builtin_amdgcn_rcpf(e0[i]); e1[i] = __builtin_amdgcn_rcpf(e1[i]); }
                        const f32x4 o0 = (f32x4){a0[0], a0[1], a0[2], a0[3]} * w0 + (f32x4){a1[0], a1[1], a1[2], a1[3]} * w1 + (f32x4){a2[0], a2[1], a2[2], a2[3]} * w2;
                        const f32x4 o1 = (f32x4){a0[4], a0[5], a0[6], a0[7]} * w0 + (f32x4){a1[4], a1[5], a1[6], a1[7]} * w1 + (f32x4){a2[4], a2[5], a2[6], a2[7]} * w2;
                        const f32x4 y0 = (o0 * z0) * e0, y1 = (o1 * z1) * e1;
                        const float y[8] = {y0[0], y0[1], y0[2], y0[3], y1[0], y1[1], y1[2], y1[3]};
                        *(u32x4*)(yb + off) = pack8(y); }
                    asm volatile("" ::: "memory"); }
        } else {
            const unsigned off0 = ((unsigned)(u.pm * 12 + (u.pn - 6)) * 8192u + (unsigned)((wr * 4 + wc) * 1024 + fq * 16 + fr)) * 8u;
#pragma unroll
            for (int ai = 0; ai < 2; ++ai)
#pragma unroll
                for (int m = 0; m < 4; ++m) {
#pragma unroll
                    for (int bj = 0; bj < 2; ++bj) { const unsigned off = off0 + (unsigned)(((ai * 4 + m) * 2 + bj) * 512);
                        f32x4 e0 = acc[ai][bj][m][0] * (-LOG2E), e1 = acc[ai][bj][m][1] * (-LOG2E); asm volatile("" : "+v"(e0), "+v"(e1));
#pragma unroll
                        for (int i = 0; i < 4; ++i) { e0[i] = __builtin_amdgcn_exp2f(e0[i]); e1[i] = __builtin_amdgcn_exp2f(e1[i]); }
                        e0 = e0 + 1.f; e1 = e1 + 1.f; asm volatile("" : "+v"(e0), "+v"(e1));
                        float g[8] = {__builtin_amdgcn_rcpf(e0[0]), __builtin_amdgcn_rcpf(e0[1]), __builtin_amdgcn_rcpf(e0[2]), __builtin_amdgcn_rcpf(e0[3]), __builtin_amdgcn_rcpf(e1[0]), __builtin_amdgcn_rcpf(e1[1]), __builtin_amdgcn_rcpf(e1[2]), __builtin_amdgcn_rcpf(e1[3])};
                        __builtin_nontemporal_store(pack8(g), (u32x4*)(gates + off)); }
                    asm volatile("" ::: "memory"); }
        }
    }
};

struct EpiBranchZ {
    static constexpr bool PERM = true, AFTER_DRAIN = false;
    const bf16_t* gates; bf16_t* merged;
    __device__ __forceinline__ void operator()(const f32x4 (&acc)[2][2][4][2], const Unit& u, int wr, int wc, int fr, int fq) const {
        const bool rmw = u.z > 0;
        const bf16_t* gt = gates + ((size_t)(u.pm * 12 + u.z * 4 + u.pn) * 8192 + (size_t)((wr * 4 + wc) * 1024 + fq * 16 + fr)) * 8;
        bf16_t* mp0 = merged + (size_t)(u.pm * BM + wr * 64 + fr) * 1024 + (u.pn * BM + wc * 32 + 8 * fq);
#pragma unroll
        for (int ai = 0; ai < 2; ++ai) {
            u32x4 gv[4][2], mv[4][2];
#pragma unroll
            for (int m = 0; m < 4; ++m)
#pragma unroll
                for (int bj = 0; bj < 2; ++bj) {
                    gv[m][bj] = __builtin_nontemporal_load((const u32x4*)(gt + ((ai * 4 + m) * 2 + bj) * 512));
                    if (rmw) mv[m][bj] = *(const u32x4*)(mp0 + (ai * HALF + m * 16) * 1024 + bj * HALF); }
            asm volatile("" ::: "memory");
#pragma unroll
            for (int m = 0; m < 4; ++m) {
#pragma unroll
                for (int bj = 0; bj < 2; ++bj) {
                    float g[8]; unpack8(gv[m][bj], g);
                    const f32x4 v0 = acc[ai][bj][m][0], v1 = acc[ai][bj][m][1];
                    float r[8] = {g[0] * v0[0], g[1] * v0[1], g[2] * v0[2], g[3] * v0[3], g[4] * v1[0], g[5] * v1[1], g[6] * v1[2], g[7] * v1[3]};
                    if (rmw) { float old[8]; unpack8(mv[m][bj], old);
#pragma unroll
                        for (int i = 0; i < 8; ++i) r[i] += old[i]; }
                    *(u32x4*)(mp0 + (ai * HALF + m * 16) * 1024 + bj * HALF) = pack8(r); }
                asm volatile("" ::: "memory"); } }
    }
};

struct EpiOut {
    static constexpr bool PERM = false, AFTER_DRAIN = false;
    const float* xin; float* xout;
    __device__ __forceinline__ void operator()(const f32x4 (&acc)[2][2][4][2], const Unit& u, int wr, int wc, int fr, int fq) const {
        const int row0 = u.pm * BM + wr * 64 + fr; const int col0 = u.pn * BM + wc * 32 + 4 * fq;
#pragma unroll
        for (int ai = 0; ai < 2; ++ai) {
            f32x4 xv[4][2][2];
#pragma unroll
            for (int m = 0; m < 4; ++m)
#pragma unroll
                for (int bj = 0; bj < 2; ++bj)
#pragma unroll
                    for (int n = 0; n < 2; ++n) xv[m][bj][n] = *(const f32x4*)(xin + (size_t)(row0 + ai * HALF + m * 16) * 1024 + col0 + bj * HALF + n * 16);
            asm volatile("" ::: "memory");
#pragma unroll
            for (int m = 0; m < 4; ++m) { const size_t off = (size_t)(row0 + ai * HALF + m * 16) * 1024 + col0;
#pragma unroll
                for (int bj = 0; bj < 2; ++bj)
#pragma unroll
                    for (int n = 0; n < 2; ++n) { const size_t o2 = off + bj * HALF + n * 16; *(f32x4*)(xout + o2) = xv[m][bj][n] + acc[ai][bj][m][n]; }
                asm volatile("" ::: "memory"); } }
    }
};


template <class Epi, class Sched, bool ALIGN_EPI = false, bool SP2 = false, size_t ZA = 0, size_t ZB = 0>
__device__ __forceinline__ void gemm_phase(PG8_LAS unsigned char* lds, const Gemm g, const Sched& S, const Epi& E) {
    int tid_l = threadIdx.x; asm volatile("" : "+v"(tid_l));
    const int tid = tid_l, wid = __builtin_amdgcn_readfirstlane(tid >> 6), lane = tid & 63, wr = wid >> 2, wc = wid & 3, fr = lane & 15, fq = lane >> 4;
    const int K = g.K, nt = K / BK;
    unsigned voffA[2], voffB[2];
#pragma unroll
    for (int i = 0; i < 2; ++i) { int R, C; stage_rc(tid * 16 + i * 8192, R, C); const int Rb = Epi::PERM ? ((R & ~31) + perm32(R & 31)) : R;
        voffA[i] = (unsigned)(R * K + C) * 2u; voffB[i] = (unsigned)(Rb * K + C) * 2u; }
    const size_t kstep = (size_t)(BK * 2);
    const size_t hstep = (size_t)HALF * K * 2;
    const size_t tstep = 2 * hstep;
    const unsigned ldsw = (unsigned)wid * 1024u;
    const int aoff = lds_byte(wr * 64 + fr, fq * 8), boff = lds_byte(wc * 32 + fr, fq * 8);
#define PG8_SA(b, h) (((b) * 2 + (h)) * HTB)
#define PG8_SB(b, h) ((4 + (b) * 2 + (h)) * HTB)
#define PG8_STAGE(bufoff, gbase, voff) do { _Pragma("unroll") for (int _i = 0; _i < 2; ++_i) \
        __builtin_amdgcn_global_load_lds((const unsigned*)((const char*)(gbase) + (voff)[_i]), (PG8_LAS unsigned*)(lds + (bufoff) + ldsw + _i * 8192), 16, 0, 0); } while (0)
#define PG8_LDA(dst, b, h) do { _Pragma("unroll") for (int m = 0; m < 4; ++m) _Pragma("unroll") for (int k = 0; k < 2; ++k) dst[m][k] = *(const PG8_LAS bf16x8*)(lds + PG8_SA(b, h) + aoff + m * 2048 + k * 1024); } while (0)
#define PG8_LDB(dst, b, h) do { _Pragma("unroll") for (int n = 0; n < 2; ++n) _Pragma("unroll") for (int k = 0; k < 2; ++k) dst[n][k] = *(const PG8_LAS bf16x8*)(lds + PG8_SB(b, h) + boff + n * 2048 + k * 1024); } while (0)
#define PG8_MMA(ai, bj, At, Bt) do { __builtin_amdgcn_s_setprio(1); _Pragma("unroll") for (int m = 0; m < 4; ++m) _Pragma("unroll") for (int n = 0; n < 2; ++n) _Pragma("unroll") for (int k = 0; k < 2; ++k) \
        acc[ai][bj][m][n] = __builtin_amdgcn_mfma_f32_16x16x32_bf16(Bt[n][k], At[m][k], acc[ai][bj][m][n], 0, 0, 0); __builtin_amdgcn_s_setprio(0); } while (0)
#define PG8_WAIT_V(n) asm volatile("s_waitcnt vmcnt(" #n ")" ::: "memory")
#define PG8_WAIT_L(n) asm volatile("s_waitcnt lgkmcnt(" #n ")" ::: "memory")
#define PG8_BAR __builtin_amdgcn_s_barrier()
#define PG8_SCHED __builtin_amdgcn_sched_barrier(0)
    Unit cur, nxt; int ui = 0;
    if (!S.next(0, cur)) return;
    f32x4 acc[2][2][4][2];
#pragma unroll
    for (int a = 0; a < 2; ++a)
#pragma unroll
        for (int b = 0; b < 2; ++b)
#pragma unroll
            for (int m = 0; m < 4; ++m)
#pragma unroll
                for (int n = 0; n < 2; ++n) acc[a][b][m][n] = (f32x4){0.f, 0.f, 0.f, 0.f};
    bf16x8 At[4][2], B0[2][2], B1[2][2];
    const char* cA = (const char*)g.A + (size_t)cur.pm * tstep + (size_t)cur.z * ZA; const char* cB = (const char*)g.Bt + (size_t)cur.pn * tstep + (size_t)cur.z * ZB;
    S.a_ready(cur);
    if constexpr (SP2) {
        PG8_STAGE(PG8_SB(0, 0), cB, voffB); PG8_STAGE(PG8_SB(0, 1), cB + hstep, voffB); PG8_STAGE(PG8_SA(0, 0), cA, voffA); PG8_STAGE(PG8_SA(0, 1), cA + hstep, voffA);
        if (wr == 1) PG8_BAR;
        PG8_WAIT_V(2); PG8_BAR;
        PG8_STAGE(PG8_SB(1, 0), cB + kstep, voffB); PG8_STAGE(PG8_SA(1, 0), cA + kstep, voffA); PG8_STAGE(PG8_SB(1, 1), cB + hstep + kstep, voffB);
        PG8_WAIT_V(6); PG8_BAR;
    } else {
        PG8_STAGE(PG8_SB(0, 0), cB, voffB); PG8_STAGE(PG8_SA(0, 0), cA, voffA); PG8_STAGE(PG8_SB(0, 1), cB + hstep, voffB); PG8_STAGE(PG8_SA(0, 1), cA + hstep, voffA);
        if (wr == 1) PG8_BAR;
        PG8_WAIT_V(4); PG8_BAR;
        PG8_STAGE(PG8_SB(1, 0), cB + kstep, voffB); PG8_STAGE(PG8_SA(1, 0), cA + kstep, voffA); PG8_STAGE(PG8_SB(1, 1), cB + hstep + kstep, voffB);
        PG8_WAIT_V(6); PG8_BAR;
    }
    for (;;) {
        const bool has_next = S.next(ui + 1, nxt);
        const char* nA = has_next ? (const char*)g.A + (size_t)nxt.pm * tstep + (size_t)nxt.z * ZA : cA; const char* nB = has_next ? (const char*)g.Bt + (size_t)nxt.pn * tstep + (size_t)nxt.z * ZB : cB;
        for (int t = 0; t < nt; t += 2) {
            const bool last = (t == nt - 2);
            const char* a1 = cA + (size_t)(t + 1) * kstep;
            const char* a2 = last ? nA : cA + (size_t)(t + 2) * kstep; const char* b2 = last ? nB : cB + (size_t)(t + 2) * kstep;
            const char* a3 = a2 + kstep; const char* b3 = b2 + kstep;
            if (last && has_next) S.a_ready(nxt);
            if constexpr (SP2) {
            PG8_LDB(B0, 0, 0); PG8_LDB(B1, 0, 1); PG8_SCHED; PG8_LDA(At, 0, 0); PG8_STAGE(PG8_SA(1, 1), a1 + hstep, voffA);
            PG8_WAIT_V(8); PG8_WAIT_L(0); PG8_BAR; PG8_MMA(0, 0, At, B0); PG8_MMA(0, 1, At, B1); PG8_BAR; PG8_SCHED;
            PG8_LDA(At, 0, 1); PG8_STAGE(PG8_SB(0, 0), b2, voffB); PG8_STAGE(PG8_SB(0, 1), b2 + hstep, voffB); PG8_STAGE(PG8_SA(0, 0), a2, voffA);
            PG8_WAIT_V(8); PG8_WAIT_L(0); PG8_BAR; PG8_MMA(1, 0, At, B0); PG8_MMA(1, 1, At, B1); PG8_BAR; PG8_SCHED;
            PG8_LDB(B0, 1, 0); PG8_LDB(B1, 1, 1); PG8_SCHED; PG8_LDA(At, 1, 0); PG8_STAGE(PG8_SA(0, 1), a2 + hstep, voffA);
            PG8_WAIT_V(8); PG8_WAIT_L(0); PG8_BAR; PG8_MMA(0, 0, At, B0); PG8_MMA(0, 1, At, B1); PG8_BAR; PG8_SCHED;
            PG8_LDA(At, 1, 1); PG8_STAGE(PG8_SB(1, 0), b3, voffB); PG8_STAGE(PG8_SB(1, 1), b3 + hstep, voffB); PG8_STAGE(PG8_SA(1, 0), a3, voffA);
            PG8_WAIT_V(8); PG8_WAIT_L(0); PG8_BAR; PG8_MMA(1, 0, At, B0); PG8_MMA(1, 1, At, B1); PG8_BAR; PG8_SCHED;
            } else {
            PG8_LDB(B0, 0, 0); PG8_SCHED; PG8_LDA(At, 0, 0); PG8_STAGE(PG8_SA(1, 1), a1 + hstep, voffA);
            PG8_WAIT_L(8); PG8_BAR; PG8_WAIT_L(0); PG8_MMA(0, 0, At, B0); PG8_BAR; PG8_SCHED;
            PG8_LDB(B1, 0, 1); PG8_STAGE(PG8_SB(0, 0), b2, voffB);
            PG8_BAR; PG8_WAIT_L(0); PG8_MMA(0, 1, At, B1); PG8_BAR;
            PG8_LDA(At, 0, 1); PG8_STAGE(PG8_SA(0, 0), a2, voffA);
            PG8_BAR; PG8_WAIT_L(0); PG8_MMA(1, 0, At, B0); PG8_BAR; PG8_SCHED;
            PG8_STAGE(PG8_SB(0, 1), b2 + hstep, voffB);
            PG8_WAIT_V(6); PG8_BAR; PG8_MMA(1, 1, At, B1); PG8_BAR;
            PG8_LDB(B0, 1, 0); PG8_SCHED; PG8_LDA(At, 1, 0); PG8_STAGE(PG8_SA(0, 1), a2 + hstep, voffA);
            PG8_WAIT_L(8); PG8_BAR; PG8_WAIT_L(0); PG8_MMA(0, 0, At, B0); PG8_BAR; PG8_SCHED;
            PG8_LDB(B1, 1, 1); PG8_STAGE(PG8_SB(1, 0), b3, voffB);
            PG8_BAR; PG8_WAIT_L(0); PG8_MMA(0, 1, At, B1); PG8_BAR;
            PG8_LDA(At, 1, 1); PG8_STAGE(PG8_SA(1, 0), a3, voffA);
            PG8_BAR; PG8_WAIT_L(0); PG8_MMA(1, 0, At, B0); PG8_BAR; PG8_SCHED;
            PG8_STAGE(PG8_SB(1, 1), b3 + hstep, voffB);
            PG8_WAIT_V(6); PG8_BAR; PG8_MMA(1, 1, At, B1); PG8_BAR;
            }
        }
        if constexpr (ALIGN_EPI) { if (wr == 0) PG8_BAR; }
        if constexpr (!Epi::AFTER_DRAIN) { E(acc, cur, wr, wc, fr, fq); S.done(cur); }
        if (!has_next) break;
#pragma unroll
        for (int a = 0; a < 2; ++a)
#pragma unroll
            for (int b = 0; b < 2; ++b)
#pragma unroll
                for (int m = 0; m < 4; ++m)
#pragma unroll
                    for (int n = 0; n < 2; ++n) acc[a][b][m][n] = (f32x4){0.f, 0.f, 0.f, 0.f};
        cur = nxt; cA = nA; cB = nB; ++ui;
        if constexpr (ALIGN_EPI) { if (wr == 1) PG8_BAR; }
    }
    PG8_WAIT_V(0);
    if constexpr (!ALIGN_EPI) { if (wr == 0) PG8_BAR; }
    PG8_BAR;
    if constexpr (Epi::AFTER_DRAIN) { E.fused(acc, cur, wr, wc, fr, fq, lds, wid, lane); S.done(cur); }
#undef PG8_SA
#undef PG8_SB
#undef PG8_STAGE
#undef PG8_LDA
#undef PG8_LDB
#undef PG8_MMA
#undef PG8_WAIT_V
#undef PG8_WAIT_L
#undef PG8_BAR
#undef PG8_SCHED
}
}

namespace att {
#define LAS __attribute__((address_space(3)))
typedef unsigned short bf16_t;
typedef short bf16x8 __attribute__((ext_vector_type(8)));
typedef short s16x4 __attribute__((ext_vector_type(4)));
typedef short v4i16_t __attribute__((ext_vector_type(4)));
typedef float f32x16 __attribute__((ext_vector_type(16)));
typedef float f32x4 __attribute__((ext_vector_type(4)));
typedef unsigned u32x4 __attribute__((ext_vector_type(4)));
typedef unsigned u32x2 __attribute__((ext_vector_type(2)));
constexpr int L_K = 0, L_V = 16384, L_B = 49152, L_MISC = 49152 + 512;
constexpr float ATT_THR = 64.f;
constexpr int L_OA = 65536;
constexpr int ATT_LDS_BYTES = L_OA + 65536;

__device__ __forceinline__ int crow(int r, int hi) { return (r & 3) + 8 * (r >> 2) + 4 * hi; }
__device__ __forceinline__ unsigned cvtpk(float lo, float hi) { typedef float f32x2_t __attribute__((ext_vector_type(2))); typedef __bf16 bf16x2_t __attribute__((ext_vector_type(2)));
    f32x2_t v = {lo, hi}; bf16x2_t b = __builtin_convertvector(v, bf16x2_t); return __builtin_bit_cast(unsigned, b); }
__device__ __forceinline__ s16x4 vtr(const LAS char* p) { return __builtin_bit_cast(s16x4, __builtin_amdgcn_ds_read_tr16_b64_v4i16((LAS v4i16_t*)p)); }
typedef float f32x8_t __attribute__((ext_vector_type(8))); typedef float f32x4_t __attribute__((ext_vector_type(4))); typedef float f32x2_t __attribute__((ext_vector_type(2)));
__device__ __forceinline__ float hsum16(const f32x16 s) {
    const f32x8_t a = __builtin_shufflevector(s, s, 0, 1, 2, 3, 4, 5, 6, 7) + __builtin_shufflevector(s, s, 8, 9, 10, 11, 12, 13, 14, 15);
    const f32x4_t b = __builtin_shufflevector(a, a, 0, 1, 2, 3) + __builtin_shufflevector(a, a, 4, 5, 6, 7);
    const f32x2_t c = __builtin_shufflevector(b, b, 0, 1) + __builtin_shufflevector(b, b, 2, 3);
    return c[0] + c[1]; }
__device__ __forceinline__ float half_max(float v) { auto rr = __builtin_amdgcn_permlane32_swap(__float_as_uint(v), __float_as_uint(v), false, false); return fmaxf(__uint_as_float(rr[0]), __uint_as_float(rr[1])); }
__device__ __forceinline__ float half_sum(float v) { auto rr = __builtin_amdgcn_permlane32_swap(__float_as_uint(v), __float_as_uint(v), false, false); return __uint_as_float(rr[0]) + __uint_as_float(rr[1]); }
#define MFMA32(a, b, c) __builtin_amdgcn_mfma_f32_32x32x16_bf16(a, b, c, 0, 0, 0)

struct PassArgs {
    const bf16_t* q;
    const bf16_t* k;
    const bf16_t* v;
    long kpitch;
    const float* kbias;
    float qbias;
    float slope2;
    int q0;
};

template <int DV, int MODE>
__device__ __forceinline__ void attn_pass(LAS char* lds, const PassArgs& a, f32x16 (&o)[DV / 32], float& m_out, float& l_out, const int tid) {
    const int lane = tid & 63, r32 = lane & 31, hi = lane >> 5;
    const int w = __builtin_amdgcn_readfirstlane(tid >> 6);
    const int qw0 = a.q0 + 32 * w, myq = qw0 + r32;
    const int t_begin = (MODE == 2 && a.q0 >= 256) ? ((a.q0 - 128) >> 6) : 0;
    const int t_end = (a.q0 + 256) >> 6;
    const int tw_hi = (qw0 + 31) >> 6;
    const int tw_lo = (MODE == 2 && qw0 > 128) ? ((qw0 - 128) >> 6) : 0;
    bf16x8 qf[4];
#pragma unroll
    for (int d0 = 0; d0 < 4; ++d0) qf[d0] = *(const bf16x8*)(a.q + d0 * 16 + hi * 8);
#pragma unroll
    for (int i = 0; i < DV / 32; ++i)
#pragma unroll
        for (int g = 0; g < 16; ++g) o[i][g] = 0.f;
    float m = -1e30f, l = 0.f;
    f32x16 kc;
#pragma unroll
    for (int g = 0; g < 16; ++g) kc[g] = (MODE == 1) ? 0.f : a.slope2 * (float)((g & 3) + 8 * (g >> 2) + 4 * hi);
    const bf16_t* ksrc = a.k + (long)lane * a.kpitch + 8 * w;
    const bf16_t* vsrc = a.v + (long)(16 * (w & 3) + (lane >> 2)) * a.kpitch + 32 * (w >> 2) + 8 * (lane & 3);
    const long tstride = 64 * a.kpitch;
#define ATT_ISSUE(t, buf) do { \
        __builtin_amdgcn_global_load_lds((const unsigned*)(ksrc + (long)(t) * tstride), (LAS unsigned*)(lds + L_K + (buf) * 8192 + w * 1024), 16, 0, 0); \
        __builtin_amdgcn_global_load_lds((const unsigned*)(vsrc + (long)(t) * tstride), (LAS unsigned*)(lds + L_V + (buf) * 16384 + w * 1024), 16, 0, 0); \
        if (DV == 128) __builtin_amdgcn_global_load_lds((const unsigned*)(vsrc + (long)(t) * tstride + 64), (LAS unsigned*)(lds + L_V + (buf) * 16384 + (w + 8) * 1024), 16, 0, 0); \
        if (MODE == 1) { if (w == 0) __builtin_amdgcn_global_load_lds((const unsigned*)(a.kbias + (t) * 64 + lane), (LAS unsigned*)(lds + L_B + (buf) * 256), 4, 0, 0); } \
    } while (0)
    ATT_ISSUE(t_begin, 0);
    __syncthreads();
    const int vlane = ((lane >> 4) & 1) * 32 + (lane & 3) * 8 + (4 * hi + ((lane & 15) >> 2)) * 64;
    for (int t = t_begin; t < t_end; ++t) {
        const int buf = (t - t_begin) & 1;
        if (t + 1 < t_end) ATT_ISSUE(t + 1, buf ^ 1);
        if (t >= tw_lo && t <= tw_hi) {
            const LAS char* kb = lds + L_K + buf * 8192 + hi * 1024 + r32 * 16;
            f32x16 p0, p1;
#pragma unroll
            for (int d0 = 0; d0 < 4; ++d0) {
                const bf16x8 k0 = *(const LAS bf16x8*)(kb + d0 * 2048), k1 = *(const LAS bf16x8*)(kb + d0 * 2048 + 512);
                if (d0 == 0) { p0 = MFMA32(k0, qf[0], kc); p1 = MFMA32(k1, qf[0], kc); }
                else { p0 = MFMA32(k0, qf[d0], p0); p1 = MFMA32(k1, qf[d0], p1); }
            }
            __builtin_amdgcn_sched_barrier(0);
            float base, c32 = 0.f;
            if (MODE == 1) {
                const LAS char* bb = lds + L_B + buf * 256 + hi * 16;
#pragma unroll
                for (int gq = 0; gq < 4; ++gq) {
                    const f32x4 c0 = *(const LAS f32x4*)(bb + gq * 32), c1 = *(const LAS f32x4*)(bb + 128 + gq * 32);
#pragma unroll
                    for (int j = 0; j < 4; ++j) { p0[4 * gq + j] -= c0[j]; p1[4 * gq + j] -= c1[j]; }
                }
                base = a.qbias;
            } else {
                base = a.slope2 * (float)(64 * t - myq); c32 = 32.f * a.slope2;
            }
            const bool bnd = (64 * t + 63 > qw0) || (MODE == 2 && 64 * t < qw0 + 31 - 128);
            if (bnd) {
                const int dq = myq - 64 * t - 4 * hi;
#pragma unroll
                for (int g = 0; g < 16; ++g) {
                    const int cg = (g & 3) + 8 * (g >> 2);
                    const bool v0 = MODE == 2 ? ((unsigned)(dq - cg) <= 128u) : (cg <= dq);
                    const bool v1 = MODE == 2 ? ((unsigned)(dq - cg - 32) <= 128u) : (cg + 32 <= dq);
                    p0[g] = v0 ? p0[g] : -INFINITY; p1[g] = v1 ? p1[g] : -INFINITY;
                }
            }
            float mx0 = p0[0], mx1 = p1[0];
#pragma unroll
            for (int g = 1; g < 16; ++g) { mx0 = fmaxf(mx0, p0[g]); mx1 = fmaxf(mx1, p1[g]); }
            float mx = half_max(fmaxf(mx0, mx1 + c32));
            const float mt_ = mx + base; const float mnew = (mt_ > m + ATT_THR) ? mt_ : m;
            const float alpha = __builtin_amdgcn_exp2f(m - mnew);
            const float mb = mnew - base, mb1 = mb - c32;
            { float nmb = -mb, nmb1 = -mb1; asm volatile("" : "+v"(nmb), "+v"(nmb1)); p0 = p0 + nmb; p1 = p1 + nmb1; }
#pragma unroll
            for (int g = 0; g < 8; ++g) p0[g] = __builtin_amdgcn_exp2f(p0[g]);
            if (__any(mnew > m)) {
#pragma unroll
                for (int i = 0; i < DV / 32; ++i)
#pragma unroll
                    for (int g = 0; g < 16; ++g) o[i][g] *= alpha;
            }
            m = mnew;
            u32x4 pw[4];
#pragma unroll
            for (int j = 0; j < 4; ++j) pw[0][j] = cvtpk(p0[2 * j], p0[2 * j + 1]);
            __builtin_amdgcn_sched_barrier(0);
            const LAS char* vb = lds + L_V + buf * 16384 + vlane;
            s16x4 lo_[2][DV / 32], hh_[2][DV / 32];
#pragma unroll
            for (int i = 0; i < DV / 32; ++i) { lo_[0][i] = vtr(vb + i * 4096); hh_[0][i] = vtr(vb + i * 4096 + 512); }
#pragma unroll
            for (int ks = 0; ks < 4; ++ks) {
                if (ks + 1 < 4) {
#pragma unroll
                    for (int i = 0; i < DV / 32; ++i) { lo_[(ks + 1) & 1][i] = vtr(vb + i * 4096 + (ks + 1) * 1024); hh_[(ks + 1) & 1][i] = vtr(vb + i * 4096 + (ks + 1) * 1024 + 512); }
                }
#pragma unroll
                for (int i = 0; i < DV / 32; ++i) { const s16x4 lo = lo_[ks & 1][i], hh = hh_[ks & 1][i]; const bf16x8 vf = (bf16x8){lo[0], lo[1], lo[2], lo[3], hh[0], hh[1], hh[2], hh[3]};
                    o[i] = MFMA32(vf, __builtin_bit_cast(bf16x8, pw[ks]), o[i]); }
                if (ks == 0) {
#pragma unroll
                    for (int g = 8; g < 16; ++g) p0[g] = __builtin_amdgcn_exp2f(p0[g]);
#pragma unroll
                    for (int j = 0; j < 4; ++j) pw[1][j] = cvtpk(p0[8 + 2 * j], p0[9 + 2 * j]);
                } else if (ks == 1) {
#pragma unroll
                    for (int g = 0; g < 8; ++g) p1[g] = __builtin_amdgcn_exp2f(p1[g]);
#pragma unroll
                    for (int j = 0; j < 4; ++j) pw[2][j] = cvtpk(p1[2 * j], p1[2 * j + 1]);
                } else if (ks == 2) {
#pragma unroll
                    for (int g = 8; g < 16; ++g) p1[g] = __builtin_amdgcn_exp2f(p1[g]);
#pragma unroll
                    for (int j = 0; j < 4; ++j) pw[3][j] = cvtpk(p1[8 + 2 * j], p1[9 + 2 * j]);
                    const float ps = hsum16(p0 + p1);
                    l = l * alpha + ps;
                }
                __builtin_amdgcn_sched_barrier(0);
            }
        }
        __syncthreads();
    }
#undef ATT_ISSUE
    m_out = m; l_out = l;
}


__device__ __forceinline__ void diff_unit(LAS char* lds, int b, int h, int qb, bf16_t* DQ, const bf16_t* DK, const bf16_t* DVb, float lam, float post, const float* gn) {
    int tid = threadIdx.x; asm volatile("" : "+v"(tid));
    const int lane = tid & 63, r32 = lane & 31, hi = lane >> 5;
    const int w = __builtin_amdgcn_readfirstlane(tid >> 6);
    const int q0 = qb * 256, myq = q0 + 32 * w + r32;
    const size_t tok0 = (size_t)b * SEQ;
    PassArgs a; a.kpitch = 512; a.kbias = nullptr; a.qbias = 0.f; a.q0 = q0;
    a.slope2 = __builtin_amdgcn_exp2f(-2.f * (float)(h + 1)) * LOG2E;
    a.q = DQ + (tok0 + myq) * 512 + (2 * h) * 64; a.k = DK + tok0 * 512 + (2 * h) * 64; a.v = DVb + tok0 * 512 + h * 128;
    f32x16 ob[4]; float m, l;
    LAS u32x4* oas = (LAS u32x4*)(lds + L_OA + w * 8192) + lane;
    attn_pass<128, 0>(lds, a, ob, m, l, tid);
    { const float inv = 1.f / half_sum(l);
#pragma unroll
      for (int i = 0; i < 4; ++i)
#pragma unroll
          for (int jj = 0; jj < 2; ++jj) { u32x4 wv;
#pragma unroll
              for (int j = 0; j < 4; ++j) wv[j] = cvtpk(ob[i][8 * jj + 2 * j] * inv, ob[i][8 * jj + 2 * j + 1] * inv);
              oas[(i * 2 + jj) * 64] = wv; } }
    a.q += 64; a.k += 64;
    attn_pass<128, 0>(lds, a, ob, m, l, tid);
    { const float f = lam / half_sum(l); float ss = 0.f;
#pragma unroll
      for (int i = 0; i < 4; ++i)
#pragma unroll
          for (int jj = 0; jj < 2; ++jj) { const u32x4 wv = oas[(i * 2 + jj) * 64];
#pragma unroll
              for (int j = 0; j < 4; ++j) { const float a0 = __uint_as_float(wv[j] << 16), a1 = __uint_as_float(wv[j] & 0xffff0000u); const int g = 8 * jj + 2 * j;
                  ob[i][g] = a0 - f * ob[i][g]; ob[i][g + 1] = a1 - f * ob[i][g + 1]; ss += ob[i][g] * ob[i][g] + ob[i][g + 1] * ob[i][g + 1]; } }
      ss = half_sum(ss);
      const float rr = post / sqrtf(ss * (1.f / 128.f) + RMS_EPS);
      bf16_t* orow = DQ + (tok0 + myq) * 512 + h * 128;
#pragma unroll
      for (int i = 0; i < 4; ++i)
#pragma unroll
          for (int gq = 0; gq < 4; ++gq) { const int dv0 = 32 * i + 8 * gq + 4 * hi; const f32x4 g4 = *(const f32x4*)(gn + dv0);
              u32x2 wv; wv.x = cvtpk(ob[i][4 * gq] * rr * g4[0], ob[i][4 * gq + 1] * rr * g4[1]); wv.y = cvtpk(ob[i][4 * gq + 2] * rr * g4[2], ob[i][4 * gq + 3] * rr * g4[3]);
              *(u32x2*)(orow + dv0) = wv; } }
}

__device__ __forceinline__ void store_o64(bf16_t* orow, const f32x16 (&o)[2], float inv, int hi) {
#pragma unroll
    for (int i = 0; i < 2; ++i)
#pragma unroll
        for (int gq = 0; gq < 4; ++gq) { const int dv0 = 32 * i + 8 * gq + 4 * hi;
            u32x2 wv; wv.x = cvtpk(o[i][4 * gq] * inv, o[i][4 * gq + 1] * inv); wv.y = cvtpk(o[i][4 * gq + 2] * inv, o[i][4 * gq + 3] * inv);
            *(u32x2*)(orow + dv0) = wv; }
}

constexpr int LP_K = 0, LP_V = 65536;
struct DilSub { bf16x8 qf[4]; f32x16 o[2]; float m, l; int q0; };
__device__ __forceinline__ void dil_tile(LAS char* lds, const float slope2, const f32x16& kc, const int t, DilSub& S, const int wq, const int hs, const int r32, const int hi, const int vlane, const bool msk0, const bool msk1) {
    const int slot = t & 3, qw0 = S.q0 + 32 * wq, myq = qw0 + r32;
    const LAS char* kb = lds + LP_K + slot * 16384 + hs * 8192 + hi * 1024 + r32 * 16;
    f32x16 p0, p1;
#pragma unroll
    for (int d0 = 0; d0 < 4; ++d0) {
        const bf16x8 k0 = *(const LAS bf16x8*)(kb + d0 * 2048), k1 = *(const LAS bf16x8*)(kb + d0 * 2048 + 512);
        if (d0 == 0) { p0 = MFMA32(k0, S.qf[0], kc); p1 = MFMA32(k1, S.qf[0], kc); }
        else { p0 = MFMA32(k0, S.qf[d0], p0); p1 = MFMA32(k1, S.qf[d0], p1); }
    }
    __builtin_amdgcn_sched_barrier(0);
    const float base = slope2 * (float)(64 * t - myq), c32 = 32.f * slope2;
    {
        const int dq = myq - 64 * t - 4 * hi;
        if (msk0) {
#pragma unroll
            for (int g = 0; g < 16; ++g) { const int cg = (g & 3) + 8 * (g >> 2); p0[g] = ((unsigned)(dq - cg) <= 128u) ? p0[g] : -INFINITY; }
        }
        if (msk1) {
#pragma unroll
            for (int g = 0; g < 16; ++g) { const int cg = (g & 3) + 8 * (g >> 2); p1[g] = ((unsigned)(dq - cg - 32) <= 128u) ? p1[g] : -INFINITY; }
        }
    }
    float mx0 = p0[0], mx1 = p1[0];
#pragma unroll
    for (int g = 1; g < 16; ++g) { mx0 = fmaxf(mx0, p0[g]); mx1 = fmaxf(mx1, p1[g]); }
    const float mx = half_max(fmaxf(mx0, mx1 + c32));
    const float mt_ = mx + base; const float mnew = (mt_ > S.m + ATT_THR) ? mt_ : S.m;
    const float alpha = __builtin_amdgcn_exp2f(S.m - mnew);
    const float mb = mnew - base, mb1 = mb - c32;
    { float nmb = -mb, nmb1 = -mb1; asm volatile("" : "+v"(nmb), "+v"(nmb1)); p0 = p0 + nmb; p1 = p1 + nmb1; }
#pragma unroll
    for (int g = 0; g < 16; ++g) p0[g] = __builtin_amdgcn_exp2f(p0[g]);
    if (__any(mnew > S.m)) {
#pragma unroll
        for (int i = 0; i < 2; ++i)
#pragma unroll
            for (int g = 0; g < 16; ++g) S.o[i][g] *= alpha;
    }
    S.m = mnew;
    u32x4 pw[4];
#pragma unroll
    for (int j = 0; j < 4; ++j) { pw[0][j] = cvtpk(p0[2 * j], p0[2 * j + 1]); pw[1][j] = cvtpk(p0[8 + 2 * j], p0[9 + 2 * j]); }
    __builtin_amdgcn_sched_barrier(0);
    const LAS char* vb = lds + LP_V + slot * 16384 + hs * 8192 + vlane;
#pragma unroll
    for (int ks = 0; ks < 4; ++ks) {
#pragma unroll
        for (int i = 0; i < 2; ++i) {
            const s16x4 lo = vtr(vb + i * 4096 + ks * 1024), hh = vtr(vb + i * 4096 + ks * 1024 + 512);
            const bf16x8 vf = (bf16x8){lo[0], lo[1], lo[2], lo[3], hh[0], hh[1], hh[2], hh[3]};
            S.o[i] = MFMA32(vf, __builtin_bit_cast(bf16x8, pw[ks]), S.o[i]);
        }
        if (ks == 0) {
#pragma unroll
            for (int g = 0; g < 16; ++g) p1[g] = __builtin_amdgcn_exp2f(p1[g]);
#pragma unroll
            for (int j = 0; j < 4; ++j) { pw[2][j] = cvtpk(p1[2 * j], p1[2 * j + 1]); pw[3][j] = cvtpk(p1[8 + 2 * j], p1[9 + 2 * j]); }
            const float ps = hsum16(p0 + p1);
            S.l = S.l * alpha + ps;
        }
        if (ks == 1) __builtin_amdgcn_sched_barrier(0);
    }
}
__device__ __forceinline__ void dil_half(LAS char* lds, const float slope2, const f32x16& kc, const int t, const int hb, DilSub& S, const int wq, const int hs, const int r32, const int hi, const int vlane, const bool msk) {
    const int slot = t & 3, qw0 = S.q0 + 32 * wq, myq = qw0 + r32;
    const LAS char* kb = lds + LP_K + slot * 16384 + hs * 8192 + hi * 1024 + r32 * 16 + hb * 512;
    f32x16 p;
#pragma unroll
    for (int d0 = 0; d0 < 4; ++d0) { const bf16x8 k = *(const LAS bf16x8*)(kb + d0 * 2048); p = MFMA32(k, S.qf[d0], d0 == 0 ? kc : p); }
    __builtin_amdgcn_sched_barrier(0);
    const float base = slope2 * (float)(64 * t + 32 * hb - myq);
    if (msk) {
        const int dq = myq - 64 * t - 32 * hb - 4 * hi;
#pragma unroll
        for (int g = 0; g < 16; ++g) { const int cg = (g & 3) + 8 * (g >> 2); p[g] = ((unsigned)(dq - cg) <= 128u) ? p[g] : -INFINITY; }
    }
    float mx0 = p[0];
#pragma unroll
    for (int g = 1; g < 16; ++g) mx0 = fmaxf(mx0, p[g]);
    const float mx = half_max(mx0);
    const float mt_ = mx + base; const float mnew = (mt_ > S.m + ATT_THR) ? mt_ : S.m;
    const float alpha = __builtin_amdgcn_exp2f(S.m - mnew);
    { float nmb = base - mnew; asm volatile("" : "+v"(nmb)); p = p + nmb; }
#pragma unroll
    for (int g = 0; g < 16; ++g) p[g] = __builtin_amdgcn_exp2f(p[g]);
    if (__any(mnew > S.m)) {
#pragma unroll
        for (int i = 0; i < 2; ++i)
#pragma unroll
            for (int g = 0; g < 16; ++g) S.o[i][g] *= alpha;
    }
    S.m = mnew;
    u32x4 pw[2];
#pragma unroll
    for (int j = 0; j < 4; ++j) { pw[0][j] = cvtpk(p[2 * j], p[2 * j + 1]); pw[1][j] = cvtpk(p[8 + 2 * j], p[9 + 2 * j]); }
    float ps = 0.f;
#pragma unroll
    for (int g = 0; g < 16; ++g) ps += p[g];
    S.l = S.l * alpha + ps;
    __builtin_amdgcn_sched_barrier(0);
    const LAS char* vb = lds + LP_V + slot * 16384 + hs * 8192 + vlane + hb * 2048;
#pragma unroll
    for (int ks = 0; ks < 2; ++ks)
#pragma unroll
        for (int i = 0; i < 2; ++i) {
            const s16x4 lo = vtr(vb + i * 4096 + ks * 1024), hh = vtr(vb + i * 4096 + ks * 1024 + 512);
            const bf16x8 vf = (bf16x8){lo[0], lo[1], lo[2], lo[3], hh[0], hh[1], hh[2], hh[3]};
            S.o[i] = MFMA32(vf, __builtin_bit_cast(bf16x8, pw[ks]), S.o[i]);
        }
}
__device__ __forceinline__ void dil_step(LAS char* lds, const float slope2, const f32x16& kc, const int t, DilSub& S, const int wq, const int hs, const int r32, const int hi, const int vlane) {
    const int qw0 = S.q0 + 32 * wq, k0 = 64 * t, k1 = 64 * t + 32;
    const bool inv0 = (k0 > qw0 + 31) || (k0 + 31 < qw0 - 128), inv1 = (k1 > qw0 + 31) || (k1 + 31 < qw0 - 128);
    const bool msk0 = !((k0 + 31 <= qw0) && (k0 >= qw0 - 97)), msk1 = !((k1 + 31 <= qw0) && (k1 >= qw0 - 97));
    if (inv0 && inv1) return;
    if (inv1) dil_half(lds, slope2, kc, t, 0, S, wq, hs, r32, hi, vlane, msk0);
    else if (inv0) dil_half(lds, slope2, kc, t, 1, S, wq, hs, r32, hi, vlane, msk1);
    else dil_tile(lds, slope2, kc, t, S, wq, hs, r32, hi, vlane, msk0, msk1);
}
__device__ __forceinline__ void dil_pair(LAS char* lds, int p, int b, int hp, int r, int j, const bf16_t* CQ, const bf16_t* CK, const bf16_t* CV, bf16_t* dilo, float* lse) {
    int tid = threadIdx.x; asm volatile("" : "+v"(tid));
    const int lane = tid & 63, r32 = lane & 31, hi = lane >> 5;
    const int w = __builtin_amdgcn_readfirstlane(tid >> 6);
    const int wq = (w & 1) | ((w >> 2) << 1), hs = (w >> 1) & 1;
    const int d = 1 << (2 * p), h = 2 * hp + hs;
    const size_t tok0 = (size_t)b * SEQ;
    const long kpitch = 512L * d;
    const float slope2 = __builtin_amdgcn_exp2f(-(float)(h + 1)) * LOG2E * (float)d;
    const bf16_t* kbase = CK + (tok0 + r) * 512 + hp * 128; const bf16_t* vbase = CV + (tok0 + r) * 512 + hp * 128;
    DilSub SA, SB; SA.q0 = 256 * j; SB.q0 = 256 * j + 128;
    const size_t tokA = tok0 + (size_t)(SA.q0 + 32 * wq + r32) * d + r, tokB = tok0 + (size_t)(SB.q0 + 32 * wq + r32) * d + r;
#pragma unroll
    for (int d0 = 0; d0 < 4; ++d0) { SA.qf[d0] = *(const bf16x8*)(CQ + tokA * 512 + h * 64 + d0 * 16 + hi * 8); SB.qf[d0] = *(const bf16x8*)(CQ + tokB * 512 + h * 64 + d0 * 16 + hi * 8); }
#pragma unroll
    for (int i = 0; i < 2; ++i)
#pragma unroll
        for (int g = 0; g < 16; ++g) { SA.o[i][g] = 0.f; SB.o[i][g] = 0.f; }
    SA.m = SB.m = -1e30f; SA.l = SB.l = 0.f;
    f32x16 kc;
#pragma unroll
    for (int g = 0; g < 16; ++g) kc[g] = slope2 * (float)((g & 3) + 8 * (g >> 2) + 4 * hi);
    const bf16_t* ksrc = kbase + (long)lane * kpitch + 8 * w;
    const bf16_t* vsrc = vbase + (long)(16 * (w & 3) + (lane >> 2)) * kpitch + 32 * (w >> 2) + 8 * (lane & 3);
    const long tstride = 64 * kpitch;
#define DP_ISSUE(t) do { const int sl_ = (t) & 3; \
        __builtin_amdgcn_global_load_lds((const unsigned*)(ksrc + (long)(t) * tstride), (LAS unsigned*)(lds + LP_K + sl_ * 16384 + w * 1024), 16, 0, 0); \
        __builtin_amdgcn_global_load_lds((const unsigned*)(ksrc + (long)(t) * tstride + 64), (LAS unsigned*)(lds + LP_K + sl_ * 16384 + 8192 + w * 1024), 16, 0, 0); \
        __builtin_amdgcn_global_load_lds((const unsigned*)(vsrc + (long)(t) * tstride), (LAS unsigned*)(lds + LP_V + sl_ * 16384 + w * 1024), 16, 0, 0); \
        __builtin_amdgcn_global_load_lds((const unsigned*)(vsrc + (long)(t) * tstride + 64), (LAS unsigned*)(lds + LP_V + sl_ * 16384 + (w + 8) * 1024), 16, 0, 0); \
    } while (0)
    const int tA_b = j > 0 ? 4 * j - 2 : 0, tA_e = 4 * j + 2, tB_b = 4 * j, tB_e = 4 * j + 4;
    DP_ISSUE(tA_b); DP_ISSUE(tA_b + 1);
    __syncthreads();
    const int vlane = ((lane >> 4) & 1) * 32 + (lane & 3) * 8 + (4 * hi + ((lane & 15) >> 2)) * 64;
    { const int qw0 = SA.q0 + 32 * wq; const int tw_hi = (qw0 + 31) >> 6, tw_lo = qw0 > 128 ? ((qw0 - 128) >> 6) : 0;
      for (int t = tA_b; t < tA_e; ++t) {
          if (t + 2 < tB_e) DP_ISSUE(t + 2);
          if (t >= tw_lo && t <= tw_hi) dil_step(lds, slope2, kc, t, SA, wq, hs, r32, hi, vlane);
          __syncthreads();
      } }
    { const float lt = half_sum(SA.l);
      store_o64(dilo + ((size_t)p * MTOK + tokA) * 512 + h * 64, SA.o, 1.f / lt, hi);
      if (hi == 0) lse[((size_t)p * MTOK + tokA) * 8 + h] = SA.m + log2f(lt); }
    { const int qw0 = SB.q0 + 32 * wq; const int tw_hi = (qw0 + 31) >> 6, tw_lo = qw0 > 128 ? ((qw0 - 128) >> 6) : 0;
      for (int t = tB_b; t < tB_e; ++t)
          if (t >= tw_lo && t <= tw_hi) dil_step(lds, slope2, kc, t, SB, wq, hs, r32, hi, vlane); }
    { const float lt = half_sum(SB.l);
      store_o64(dilo + ((size_t)p * MTOK + tokB) * 512 + h * 64, SB.o, 1.f / lt, hi);
      if (hi == 0) lse[((size_t)p * MTOK + tokB) * 8 + h] = SB.m + log2f(lt); }
#undef DP_ISSUE
}
constexpr int N_DIFF_UNITS = 512, N_FOX_UNITS = 1024, N_DIL_UNITS = 1536, N_ATT_UNITS = N_DIFF_UNITS + N_FOX_UNITS + N_DIL_UNITS;
#undef LAS
}

namespace af {
#define LAS __attribute__((address_space(3)))
typedef unsigned short bf16_t;
using bf16x8=__attribute__((ext_vector_type(8)))short;
using s16x4=__attribute__((ext_vector_type(4)))short;
using f32x16=__attribute__((ext_vector_type(16)))float;
using f32x4=__attribute__((ext_vector_type(4)))float;
using u32x4=__attribute__((ext_vector_type(4)))unsigned;
constexpr int PITCH=512;
constexpr int NW=8,QBLK=32,QB=QBLK*NW,KVBLK=64;
__device__ __forceinline__ int crow(int r,int hi){return (r&3)+8*(r>>2)+4*hi;}
#define SBAR() __builtin_amdgcn_sched_barrier(0)
__device__ __forceinline__ void cmask(f32x16&p0,f32x16&p1,int jb,int qrel,int hi){
  const float NEG=-INFINITY; int kb=64*jb+4*hi;
  #pragma unroll
  for(int r=0;r<16;++r){int kv=kb+(r&3)+8*(r>>2); if(kv>qrel)p0[r]=NEG; if(kv+32>qrel)p1[r]=NEG;}
}
constexpr int NSLOT=3, SLOTB=8192;
constexpr int LDS_K=0, LDS_V=NSLOT*SLOTB, LDS_WS=2*NSLOT*SLOTB, LDS_BIAS=LDS_WS+NW*64*4, LDS_OST=LDS_BIAS+NW*3*256, LDS_MISC=LDS_OST+2*NW*4096, LDS_BYTES=LDS_MISC+64;
__device__ __forceinline__ void glds16(const void*sbase,unsigned voff,unsigned lds_dst){unsigned keep;
  asm volatile("s_mov_b32 %0, m0\n\ts_mov_b32 m0, %3\n\ts_nop 4\n\tglobal_load_lds_dwordx4 %1, %2\n\ts_mov_b32 m0, %0":"=&s"(keep):"v"(voff),"s"(sbase),"s"(lds_dst):"memory");}
__device__ __forceinline__ void glds4(const void*sbase,unsigned voff,unsigned lds_dst){unsigned keep;
  asm volatile("s_mov_b32 %0, m0\n\ts_mov_b32 m0, %3\n\ts_nop 4\n\tglobal_load_lds_dword %1, %2\n\ts_mov_b32 m0, %0":"=&s"(keep):"v"(voff),"s"(sbase),"s"(lds_dst):"memory");}
__device__ __forceinline__ float max3f(float a,float b,float c){float r;asm("v_max3_f32 %0, %1, %2, %3":"=v"(r):"v"(a),"v"(b),"v"(c));return r;}
__device__ __forceinline__ float max2f(float a,float b){float r;asm("v_max_f32_e32 %0, %1, %2":"=v"(r):"v"(a),"v"(b));return r;}
__device__ __forceinline__ float fadd_s(float a,float b){float r;asm("v_add_f32_e32 %0, %1, %2":"=v"(r):"v"(a),"v"(b));return r;}
__device__ __forceinline__ float fsub_s(float a,float b){float r;asm("v_sub_f32_e32 %0, %1, %2":"=v"(r):"v"(a),"v"(b));return r;}
typedef float f32x2_t __attribute__((ext_vector_type(2))); typedef __bf16 bf16x2_t __attribute__((ext_vector_type(2)));
__device__ __forceinline__ unsigned cvtpk_s(float lo,float hi){f32x2_t v={lo,hi};bf16x2_t b=__builtin_convertvector(v,bf16x2_t);return __builtin_bit_cast(unsigned,b);}
#define WAIT_BAR(N) asm volatile("s_waitcnt vmcnt(" #N ") lgkmcnt(0)\n\ts_barrier":::"memory")
typedef LAS const char* lds_cptr;
typedef short v4i16_t __attribute__((ext_vector_type(4)));
__device__ __forceinline__ void qkt(f32x16&p0,f32x16&p1,lds_cptr Kslot,const bf16x8*qr,int r32,int hi){
  const lds_cptr kb=Kslot+hi*1024+r32*16;
  #pragma unroll
  for(int d0=0;d0<4;++d0){
    const bf16x8 b0=*(const LAS bf16x8*)(kb+d0*2048);
    const bf16x8 b1=*(const LAS bf16x8*)(kb+d0*2048+512);
    p0=__builtin_amdgcn_mfma_f32_32x32x16_bf16(b0,qr[d0],p0,0,0,0);p1=__builtin_amdgcn_mfma_f32_32x32x16_bf16(b1,qr[d0],p1,0,0,0);}
}
__device__ __forceinline__ void kload8(bf16x8*kf,lds_cptr kp){
  kf[0]=*(const LAS bf16x8*)(kp);      kf[1]=*(const LAS bf16x8*)(kp+512);
  kf[2]=*(const LAS bf16x8*)(kp+2048); kf[3]=*(const LAS bf16x8*)(kp+2560);
  kf[4]=*(const LAS bf16x8*)(kp+4096); kf[5]=*(const LAS bf16x8*)(kp+4608);
  kf[6]=*(const LAS bf16x8*)(kp+6144); kf[7]=*(const LAS bf16x8*)(kp+6656);
}
__device__ __forceinline__ void kload2(bf16x8*kf,lds_cptr kp,int j){ kf[2*j]=*(const LAS bf16x8*)(kp+j*2048); kf[2*j+1]=*(const LAS bf16x8*)(kp+j*2048+512); }
__device__ __forceinline__ s16x4 vtr(lds_cptr p){ return __builtin_bit_cast(s16x4,__builtin_amdgcn_ds_read_tr16_b64_v4i16((LAS v4i16_t*)p)); }
__device__ __forceinline__ float rowmax(const f32x16&p0,const f32x16&p1){
  float a=max3f(p0[0],p0[1],p1[0]),b=max3f(p0[2],p0[3],p1[1]);a=max3f(a,p1[2],p1[3]);
  #pragma unroll
  for(int r=4;r<16;r+=4){a=max3f(a,p0[r],p0[r+1]);b=max3f(b,p0[r+2],p0[r+3]);a=max3f(a,p1[r],p1[r+1]);b=max3f(b,p1[r+2],p1[r+3]);}
  const float m=max2f(a,b);
  auto rr=__builtin_amdgcn_permlane32_swap(__float_as_uint(m),__float_as_uint(m),false,false);
  return max2f(__uint_as_float(rr[0]),__uint_as_float(rr[1]));
}
__device__ __forceinline__ void pv(f32x16*o,int vb,bf16x8 pa0,bf16x8 pa1,bf16x8 pa2,bf16x8 pa3){
  #pragma unroll
  for(int d0=0;d0<2;++d0){s16x4 lo[4],hi[4];
    #pragma unroll
    for(int ks=0;ks<4;++ks){
      asm volatile("ds_read_b64_tr_b16 %0,%1 offset:%c2":"=&v"(lo[ks]):"v"(vb),"i"(d0*4096+ks*1024):"memory");
      asm volatile("ds_read_b64_tr_b16 %0,%1 offset:%c2":"=&v"(hi[ks]):"v"(vb),"i"(d0*4096+ks*1024+512):"memory");}
    asm volatile("s_waitcnt lgkmcnt(0)":::"memory");SBAR();
    #define PK(k) (bf16x8){lo[k][0],lo[k][1],lo[k][2],lo[k][3],hi[k][0],hi[k][1],hi[k][2],hi[k][3]}
    o[d0]=__builtin_amdgcn_mfma_f32_32x32x16_bf16(pa0,PK(0),o[d0],0,0,0);
    o[d0]=__builtin_amdgcn_mfma_f32_32x32x16_bf16(pa1,PK(1),o[d0],0,0,0);
    o[d0]=__builtin_amdgcn_mfma_f32_32x32x16_bf16(pa2,PK(2),o[d0],0,0,0);
    o[d0]=__builtin_amdgcn_mfma_f32_32x32x16_bf16(pa3,PK(3),o[d0],0,0,0);
    #undef PK
  }
}
template<int THRL,int EPI,int STAGE> __device__ __forceinline__ void fast_pass(const bf16_t*Qrows,const bf16_t*Kh,const bf16_t*Vh,const float*kbias,int qb,LAS char*shm,float f,int tid){
  constexpr int stage=STAGE;
  const int lane=tid&63,r32=lane&31,hi=lane>>5; const int wid=__builtin_amdgcn_readfirstlane(tid>>6);
  const int q0=qb*QB;
  const bf16_t*Qw=Qrows+(long)(wid*QBLK)*PITCH;
  const unsigned lds0=(unsigned)(uintptr_t)shm;
  LAS float*wsf=(LAS float*)(shm+LDS_WS)+wid*64;
  const LAS float*bias0=(const LAS float*)(shm+LDS_BIAS+wid*768);
  const unsigned koff=(unsigned)(lane*PITCH+wid*8)*2u;
  const unsigned voff=(unsigned)((16*(wid&3)+(lane>>2))*PITCH+(wid>>2)*32+(lane&3)*8)*2u;
  const unsigned boff=(unsigned)lane*4u;
  const unsigned kdst=lds0+LDS_K+wid*1024, vdst=lds0+LDS_V+wid*1024, bdst=lds0+LDS_BIAS+wid*768;
  #define DMA_K(t,slot) glds16(Kh+(long)(t)*KVBLK*PITCH,koff,(unsigned)__builtin_amdgcn_readfirstlane(kdst+(slot)))
  #define DMA_V(t,slot) glds16(Vh+(long)(t)*KVBLK*PITCH,voff,(unsigned)__builtin_amdgcn_readfirstlane(vdst+(slot)))
  #define DMA_B(t,slot) glds4(kbias+(t)*KVBLK,boff,(unsigned)__builtin_amdgcn_readfirstlane(bdst+((slot)>>5)))
  const int vb0=(int)(lds0+LDS_V)+((lane>>4)&1)*32+(lane&3)*8+(4*hi+((lane&15)>>2))*64;
  const lds_cptr shm3=(lds_cptr)shm; bf16x8 kf[8];
  const lds_cptr kp0=shm3+LDS_K+hi*1024+r32*16; const lds_cptr vp0=shm3+LDS_V+((lane>>4)&1)*32+(lane&3)*8+(4*hi+((lane&15)>>2))*64;
  const int NT=(q0+QB)/KVBLK;
  DMA_K(0,0);DMA_V(0,0);DMA_K(1,SLOTB);DMA_B(0,0);DMA_B(1,SLOTB);
  bf16x8 qr[4];
  #pragma unroll
  for(int d0=0;d0<4;++d0)qr[d0]=*reinterpret_cast<const bf16x8*>(&Qw[(long)r32*PITCH+d0*16+hi*8]);
  float mhat=0.f,l_reg=0.f;f32x16 o[2];o[0]=f32x16{};o[1]=f32x16{};
  const int qrel=wid*QBLK+r32;
  #define CMASK(P0,P1,t) do{int jb_=(t)-(NT-4); if(jb_>=0)cmask(P0,P1,jb_,qrel,hi);}while(0)
  #define NMB(nm0,nm1) do{ const LAS float* bs_=bias0+(sl_cur>>7); const float nmh_=-mhat; \
    _Pragma("unroll") for(int gq=0;gq<4;++gq){ const f32x4 c0_=*(const LAS f32x4*)(bs_+8*gq+4*hi), c1_=*(const LAS f32x4*)(bs_+32+8*gq+4*hi); \
      _Pragma("unroll") for(int j=0;j<4;++j){ nm0[4*gq+j]=nmh_-c0_[j]; nm1[4*gq+j]=nmh_-c1_[j]; } } }while(0)
  bool resc=false;
  #define START(P0,P1) do{ const float rm=rowmax(P0,P1); resc=false; \
    { const float dl=rm; mhat=fadd_s(mhat,dl); \
      _Pragma("unroll") for(int r=0;r<16;++r){P0[r]=fsub_s(P0[r],dl);P1[r]=fsub_s(P1[r],dl);} } \
    _Pragma("unroll") for(int r=0;r<16;++r)P0[r]=__builtin_amdgcn_exp2f(P0[r]); }while(0)
  #define RESC() do{ if(resc){ asm volatile("s_waitcnt lgkmcnt(0)":::"memory"); \
      _Pragma("unroll") for(int d_=0;d_<2;++d_) _Pragma("unroll") for(int r=0;r<16;++r)o[d_][r]*=wsf[crow(r,hi)]; } }while(0)
  f32x16 pA0,pA1,pB0,pB1;
  int sl_prev=0,sl_cur=0,sl_next=SLOTB;
  #define ROT() do{sl_prev=sl_cur;sl_cur=sl_next;sl_next=(sl_next==(NSLOT-1)*SLOTB)?0:sl_next+SLOTB;}while(0)
  DMA_K(2,2*SLOTB);
  WAIT_BAR(3);
  NMB(pA0,pA1);
  qkt(pA0,pA1,shm3+LDS_K,qr,r32,hi);asm volatile("s_nop 15\n\ts_nop 7":"+v"(pA0),"+v"(pA1));CMASK(pA0,pA1,0);
  START(pA0,pA1);
  _Pragma("unroll") for(int r=0;r<16;++r)pA1[r]=__builtin_amdgcn_exp2f(pA1[r]);
  WAIT_BAR(0);
  DMA_K(3,0);DMA_V(1,SLOTB);DMA_B(2,2*SLOTB);
  ROT();
  kload8(kf,kp0+sl_cur);
  WAIT_BAR(3);
  s16x4 vlo[8],vhi[8]; u32x4 pw0,pw1,pw2,pw3;
  #define PKW(P,B) cvtpk_s(P[B],P[B+1])
  #define PAF(k) __builtin_bit_cast(bf16x8,pw##k)
  #define VFR(i) (bf16x8){vlo[i][0],vlo[i][1],vlo[i][2],vlo[i][3],vhi[i][0],vhi[i][1],vhi[i][2],vhi[i][3]}
  #define PIN(x) asm volatile("":"+v"(x))
  #define MX3(a,b,c) __builtin_fmaxf(__builtin_fmaxf((a),(b)),(c))
  #define GAPA(MF,A0,A1,A2,A3,W0,W1,PW) do{ MF; sacc+=A0; sacc+=A1; sacc+=A2; sacc+=A3; PIN(sacc); W0; W1; PIN(PW); SBAR(); }while(0)
  #define EX(v) __builtin_amdgcn_exp2f(v)
  #define GAPB(MF,X,B) do{ MF; X[B]=EX(X[B]); X[B+1]=EX(X[B+1]); X[B+2]=EX(X[B+2]); X[B+3]=EX(X[B+3]); PIN(X); SBAR(); }while(0)
  #define VRD(i) do{ vlo[i]=vtr(vp_+(((i)>>2)*4096+((i)&3)*1024)); vhi[i]=vtr(vp_+(((i)>>2)*4096+((i)&3)*1024+512)); }while(0)
  #define KRD(G,j) do{ if(G){ kload2(kf,kp0+sl_next,j); SBAR(); } }while(0)
  #define STEP(C0,C1,P0,P1,t,GK,GV,GL,GB) do{ NMB(C0,C1); SBAR(); \
    const lds_cptr vp_=vp0+sl_prev; \
    VRD(0); SBAR(); float sacc=(P0[0]+P0[1]); \
    GAPA(C0=__builtin_amdgcn_mfma_f32_32x32x16_bf16(kf[0],qr[0],C0,0,0,0), P0[2],P0[3],P0[4],P0[5],     pw0[0]=PKW(P0,0), pw0[1]=PKW(P0,2), pw0); \
    VRD(4); SBAR(); GAPA(C1=__builtin_amdgcn_mfma_f32_32x32x16_bf16(kf[1],qr[0],C1,0,0,0), P0[6],P0[7],P0[8],P0[9],     pw0[2]=PKW(P0,4), pw0[3]=PKW(P0,6), pw0); \
    VRD(1); SBAR(); GAPA(C0=__builtin_amdgcn_mfma_f32_32x32x16_bf16(kf[2],qr[1],C0,0,0,0),   P0[10],P0[11],P0[12],P0[13], pw1[0]=PKW(P0,8), pw1[1]=PKW(P0,10), pw1); \
    VRD(5); SBAR(); GAPA(C1=__builtin_amdgcn_mfma_f32_32x32x16_bf16(kf[3],qr[1],C1,0,0,0),   P0[14],P0[15],P1[0],P1[1],   pw1[2]=PKW(P0,12),pw1[3]=PKW(P0,14), pw1); \
    VRD(2); SBAR(); GAPA(C0=__builtin_amdgcn_mfma_f32_32x32x16_bf16(kf[4],qr[2],C0,0,0,0),   P1[2],P1[3],P1[4],P1[5],     pw2[0]=PKW(P1,0), pw2[1]=PKW(P1,2), pw2); \
    VRD(6); SBAR(); GAPA(C1=__builtin_amdgcn_mfma_f32_32x32x16_bf16(kf[5],qr[2],C1,0,0,0),   P1[6],P1[7],P1[8],P1[9],     pw2[2]=PKW(P1,4), pw2[3]=PKW(P1,6), pw2); \
    VRD(3); SBAR(); GAPA(C0=__builtin_amdgcn_mfma_f32_32x32x16_bf16(kf[6],qr[3],C0,0,0,0),   P1[10],P1[11],P1[12],P1[13], pw3[0]=PKW(P1,8), pw3[1]=PKW(P1,10), pw3); \
    VRD(7); SBAR(); GAPA(C1=__builtin_amdgcn_mfma_f32_32x32x16_bf16(kf[7],qr[3],C1,0,0,0),   P1[14],P1[15],0.f,0.f,       pw3[2]=PKW(P1,12),pw3[3]=PKW(P1,14), pw3); \
    l_reg+=sacc; \
    if(GK){DMA_K((t)+3,sl_cur);} if(GV){DMA_V((t)+1,sl_next);} if(GB){DMA_B((t)+2,sl_prev);} \
    CMASK(C0,C1,t); \
    { float a=MX3(C0[0],C0[1],C1[0]),b=MX3(C0[2],C0[3],C1[1]); a=MX3(a,C1[2],C1[3]); \
      _Pragma("unroll") for(int r=4;r<16;r+=4){a=MX3(a,C0[r],C0[r+1]);b=MX3(b,C0[r+2],C0[r+3]);a=MX3(a,C1[r],C1[r+1]);b=MX3(b,C1[r+2],C1[r+3]);} \
      float rm=__builtin_fmaxf(a,b); { auto rr=__builtin_amdgcn_permlane32_swap(__float_as_uint(rm),__float_as_uint(rm),false,false); rm=__builtin_fmaxf(__uint_as_float(rr[0]),__uint_as_float(rr[1])); } \
      resc=false; \
      if(__builtin_expect(__any(rm>(float)THRL),0)){ const float dl=__builtin_fmaxf(rm,0.f); mhat+=dl; \
        _Pragma("unroll") for(int r=0;r<16;++r){C0[r]-=dl;C1[r]-=dl;} \
        const float f_=__builtin_amdgcn_exp2f(-dl); l_reg*=f_; if(hi==0)wsf[r32]=f_; resc=true; } } \
    SBAR(); \
    GAPB(o[0]=__builtin_amdgcn_mfma_f32_32x32x16_bf16(PAF(0),VFR(0),o[0],0,0,0), C0,0); \
    GAPB(o[1]=__builtin_amdgcn_mfma_f32_32x32x16_bf16(PAF(0),VFR(4),o[1],0,0,0), C0,4); \
    KRD(GL,0); GAPB(o[0]=__builtin_amdgcn_mfma_f32_32x32x16_bf16(PAF(1),VFR(1),o[0],0,0,0), C0,8); \
    KRD(GL,1); GAPB(o[1]=__builtin_amdgcn_mfma_f32_32x32x16_bf16(PAF(1),VFR(5),o[1],0,0,0), C0,12); \
    KRD(GL,2); GAPB(o[0]=__builtin_amdgcn_mfma_f32_32x32x16_bf16(PAF(2),VFR(2),o[0],0,0,0), C1,0); \
    KRD(GL,3); GAPB(o[1]=__builtin_amdgcn_mfma_f32_32x32x16_bf16(PAF(2),VFR(6),o[1],0,0,0), C1,4); \
    GAPB(o[0]=__builtin_amdgcn_mfma_f32_32x32x16_bf16(PAF(3),VFR(3),o[0],0,0,0), C1,8); \
    GAPB(o[1]=__builtin_amdgcn_mfma_f32_32x32x16_bf16(PAF(3),VFR(7),o[1],0,0,0), C1,12); \
    }while(0)
  int t=1;
  #undef CMASK
  #define CMASK(P0,P1,t) do{}while(0)
  for(;t+5<NT;t+=2){
    STEP(pB0,pB1,pA0,pA1,t,true,true,true,true);     WAIT_BAR(3); RESC(); ROT();
    STEP(pA0,pA1,pB0,pB1,t+1,true,true,true,true);   WAIT_BAR(3); RESC(); ROT();
  }
  #undef CMASK
  #define CMASK(P0,P1,t) do{int jb_=(t)-(NT-4); if(jb_>=0)cmask(P0,P1,jb_,qrel,hi);}while(0)
  #define ENDW(tt) do{ if((tt)+3<NT){WAIT_BAR(3);} else if((tt)+2<NT){WAIT_BAR(2);} else {WAIT_BAR(0);} }while(0)
  for(;t+1<NT;t+=2){
    STEP(pB0,pB1,pA0,pA1,t,(t+3<NT),(t+1<NT),(t+1<NT),(t+2<NT));       ENDW(t);   RESC(); ROT();
    STEP(pA0,pA1,pB0,pB1,t+1,(t+4<NT),(t+2<NT),(t+2<NT),(t+3<NT));     ENDW(t+1); RESC(); ROT();
  }
  STEP(pB0,pB1,pA0,pA1,NT-1,false,false,false,false); RESC();
  { float sacc=pB0[0]+pB0[1]; _Pragma("unroll") for(int r=2;r<16;++r)sacc+=pB0[r]; _Pragma("unroll") for(int r=0;r<16;++r)sacc+=pB1[r]; l_reg+=sacc;
    pw0=(u32x4){PKW(pB0,0),PKW(pB0,2),PKW(pB0,4),PKW(pB0,6)};pw1=(u32x4){PKW(pB0,8),PKW(pB0,10),PKW(pB0,12),PKW(pB0,14)};pw2=(u32x4){PKW(pB1,0),PKW(pB1,2),PKW(pB1,4),PKW(pB1,6)};pw3=(u32x4){PKW(pB1,8),PKW(pB1,10),PKW(pB1,12),PKW(pB1,14)};
    SBAR(); pv(o,vb0+sl_cur,PAF(0),PAF(1),PAF(2),PAF(3)); }
  #undef PKW
  #undef PAF
  #undef VFR
  #undef PIN
  #undef MX3
  #undef GAPA
  #undef GAPB
  #undef EX
  #undef VRD
  #undef KRD
  #undef STEP
  #undef ENDW
  #undef NMB
  {auto rr=__builtin_amdgcn_permlane32_swap(__float_as_uint(l_reg),__float_as_uint(l_reg),false,false);l_reg=__uint_as_float(rr[0])+__uint_as_float(rr[1]);}
  if(hi==0)wsf[32+r32]=l_reg;asm volatile("s_waitcnt lgkmcnt(0)":::"memory");
  float rli[16];
  #pragma unroll
  for(int r=0;r<16;++r)rli[r]=__builtin_amdgcn_rcpf(wsf[32+crow(r,hi)]);
  { LAS bf16_t*stg=(LAS bf16_t*)(shm+LDS_OST+(stage*NW+wid)*4096);
    #pragma unroll
    for(int r=0;r<16;++r){const int orow=crow(r,hi);
      #pragma unroll
      for(int d0=0;d0<2;++d0){ const int idx=orow*64+d0*32+r32; float val=o[d0][r]*rli[r];
        if(EPI==1) val=__uint_as_float(((unsigned)stg[idx])<<16)-f*val;
        stg[idx]=(bf16_t)(cvtpk_s(val,0.f)&0xffffu); } } }
  asm volatile("s_waitcnt lgkmcnt(0)\n\ts_barrier":::"memory");
  #undef DMA_K
  #undef DMA_V
  #undef DMA_B
  #undef CMASK
  #undef START
  #undef RESC
  #undef ROT
}
#undef SBAR
#undef WAIT_BAR

__device__ __forceinline__ void fox_final(LAS char*shm,bf16_t*Qrows,int tid){
  const int lane=tid&63; const int wid=__builtin_amdgcn_readfirstlane(tid>>6);
  const LAS bf16_t*stg=(const LAS bf16_t*)(shm+LDS_OST+wid*4096); bf16_t*Ow=Qrows+(size_t)(wid*QBLK)*PITCH;
  #pragma unroll
  for(int i=0;i<4;++i){const int row=i*8+(lane>>3),ch=lane&7; const u32x4 v=*(const LAS u32x4*)(stg+row*64+ch*8); *(u32x4*)(Ow+(size_t)row*PITCH+ch*8)=v;}
}
__device__ __forceinline__ void diff_final(LAS char*shm,bf16_t*Qrows,float post,const float*gn,int tid){
  const int lane=tid&63; const int wid=__builtin_amdgcn_readfirstlane(tid>>6);
  const int row=lane>>1,hv=lane&1;
  const LAS bf16_t*stg=(const LAS bf16_t*)(shm+LDS_OST+(hv*NW+wid)*4096)+row*64;
  float v[64]; float ss=0.f;
  #pragma unroll
  for(int c=0;c<8;++c){ const u32x4 w=*(const LAS u32x4*)(stg+c*8);
    #pragma unroll
    for(int j=0;j<4;++j){ v[8*c+2*j]=__uint_as_float(w[j]<<16); v[8*c+2*j+1]=__uint_as_float(w[j]&0xffff0000u); ss+=v[8*c+2*j]*v[8*c+2*j]+v[8*c+2*j+1]*v[8*c+2*j+1]; } }
  ss+=__shfl_xor(ss,1);
  const float rr=post/sqrtf(ss*(1.f/128.f)+RMS_EPS);
  bf16_t*orow=Qrows+(size_t)(wid*QBLK+row)*PITCH+hv*64; const float*g=gn+hv*64;
  #pragma unroll
  for(int c=0;c<8;++c){ const f32x4 g0=*(const f32x4*)(g+8*c), g1=*(const f32x4*)(g+8*c+4); u32x4 w;
    w[0]=cvtpk_s(v[8*c]*rr*g0[0],v[8*c+1]*rr*g0[1]); w[1]=cvtpk_s(v[8*c+2]*rr*g0[2],v[8*c+3]*rr*g0[3]); w[2]=cvtpk_s(v[8*c+4]*rr*g1[0],v[8*c+5]*rr*g1[1]); w[3]=cvtpk_s(v[8*c+6]*rr*g1[2],v[8*c+7]*rr*g1[3]);
    *(u32x4*)(orow+8*c)=w; }
}
#undef LAS
}

#define LAS __attribute__((address_space(3)))
typedef unsigned short bf16;
typedef unsigned v4u __attribute__((ext_vector_type(4)));
typedef float f32x4 __attribute__((ext_vector_type(4)));
constexpr int NWAVES = 8;
constexpr int RING_BYTES = 131072;
constexpr int LDSCTL_OFF = RING_BYTES;
constexpr int LDS_BYTES = 139264;
static_assert(att::ATT_LDS_BYTES <= RING_BYTES && af::LDS_BYTES <= RING_BYTES && att::L_B + 512 <= af::LDS_MISC, "attention scratch fits the ring region");

__device__ __forceinline__ unsigned f2bf(float f) { unsigned u = __builtin_bit_cast(unsigned, f); return (u + 0x7fffu + ((u >> 16) & 1u)) >> 16; }
__device__ __forceinline__ unsigned pk2(float lo, float hi) { return f2bf(lo) | (f2bf(hi) << 16); }
__device__ __forceinline__ float wave_sum(float v) {
#pragma unroll
    for (int o = 1; o < 64; o <<= 1) v += __shfl_xor(v, o);
    return v;
}
__device__ __forceinline__ void transpose_item(const float* W, int ldw, int K, bf16* WT, LAS float* scr, int kb, int lane) {
    const int k0 = 64 * kb;
    float t[32];
#pragma unroll
    for (int i = 0; i < 32; ++i) { const int kk = 2 * i + (lane >> 5); t[i] = __builtin_nontemporal_load(W + (size_t)(k0 + kk) * ldw + (lane & 31)); }
    asm volatile("" ::: "memory");
#pragma unroll
    for (int i = 0; i < 32; ++i) { const int kk = 2 * i + (lane >> 5); scr[kk * 33 + (lane & 31)] = t[i]; }
    asm volatile("s_waitcnt lgkmcnt(0)" ::: "memory");
    const int c = lane & 7;
#pragma unroll
    for (int j = 0; j < 4; ++j) { const int n = (lane >> 3) + 8 * j; const LAS float* s = scr + (8 * c) * 33 + n;
        v4u o; o.x = pk2(s[0 * 33], s[1 * 33]); o.y = pk2(s[2 * 33], s[3 * 33]); o.z = pk2(s[4 * 33], s[5 * 33]); o.w = pk2(s[6 * 33], s[7 * 33]);
        *(v4u*)(WT + (size_t)n * K + k0 + 8 * c) = o; }
    asm volatile("s_waitcnt lgkmcnt(0)" ::: "memory");
}
__device__ __forceinline__ int src_col_qkv(int n) { const int s = n >> 9; const int c = s == 0 ? 0 : s == 1 ? 2048 : s == 2 ? 4104 : s == 3 ? 512 : s == 4 ? 1024 : s == 5 ? 2560 : s == 6 ? 3072 : s == 7 ? 4616 : 5128; return c + (n & 511); }
__device__ __forceinline__ int src_col_zg(int n) { if (n >= 1536) return 6152 + (n - 1536); const int s = n >> 9; return (s == 0 ? 1536 : s == 1 ? 3592 : 5640) + (n & 511); }

#define XB_TMO      128
#define XB_XCNT(j)  (256  + 64 * (j))
#define XB_XSUB(j)  (1280 + 64 * (j))
#define XB_XGEN(j)  (2304 + 64 * (j))
#define XB_TOP      3328
#define XB_TOPGEN   3392
#define XCD_BAR_WORDS 3456
#define XB_SPIN_CAP (1u << 24)

__device__ __forceinline__ unsigned xb_ld(unsigned* p)              { return __hip_atomic_load(p, __ATOMIC_RELAXED, __HIP_MEMORY_SCOPE_AGENT); }
__device__ __forceinline__ unsigned xb_add(unsigned* p, unsigned v) { return __hip_atomic_fetch_add(p, v, __ATOMIC_RELAXED, __HIP_MEMORY_SCOPE_AGENT); }
__device__ __forceinline__ unsigned xb_xcc_id() { return (unsigned)__builtin_amdgcn_s_getreg((3 << 11) | 20) & 0xFu; }
#define XB_SPIN(cond, bar) do { unsigned _sp = 0; while (cond) { __builtin_amdgcn_s_sleep(1); \
    if ((++_sp & 255u) == 0u) { if (xb_ld(&(bar)[XB_TMO])) break; if (_sp > XB_SPIN_CAP) { atomicAdd(&(bar)[XB_TMO], 1u); break; } } } } while (0)

struct XcdBarrier {
    unsigned* bar; unsigned x;
    volatile LAS unsigned* st;
};

__device__ __forceinline__ XcdBarrier xcd_barrier_post(unsigned* bar, volatile LAS unsigned* st) {
    XcdBarrier b; b.bar = bar; b.x = xb_xcc_id(); b.st = st;
    if (threadIdx.x == 0) (void)xb_add(&bar[XB_XCNT(b.x)], 1u);
    return b;
}
__device__ __forceinline__ void xcd_barrier_complete(unsigned* bar, unsigned x, unsigned& nloc, unsigned& nx) {
    const unsigned G = gridDim.x * gridDim.y * gridDim.z;
    unsigned sum, cnt, mine, sp = 0u;
    for (;;) {
        sum = 0u; cnt = 0u; mine = 0u;
#pragma unroll
        for (unsigned j = 0; j < 16; ++j) { const unsigned c = xb_ld(&bar[XB_XCNT(j)]); sum += c; cnt += (c > 0u) ? 1u : 0u; mine = (j == x) ? c : mine; }
        if (sum == G) break;
        __builtin_amdgcn_s_sleep(1);
        if ((++sp & 255u) == 0u) { if (xb_ld(&bar[XB_TMO])) break; if (sp > XB_SPIN_CAP) { atomicAdd(&bar[XB_TMO], 1u); break; } }
    }
    nloc = mine > 0u ? mine : 1u; nx = cnt > 0u ? cnt : 1u;
}

__device__ __forceinline__ void xcd_barrier(const XcdBarrier& b) {
    asm volatile("s_waitcnt vmcnt(0)" ::: "memory");
    __syncthreads();
    if (threadIdx.x == 0) {
        unsigned* bar = b.bar;
        __builtin_amdgcn_s_waitcnt(0);
        unsigned nloc = b.st[0], nx = b.st[1];
        if (nloc == 0u) { xcd_barrier_complete(bar, b.x, nloc, nx); b.st[0] = nloc; b.st[1] = nx; }
        const unsigned old = xb_add(&bar[XB_XSUB(b.x)], 1u);
        const unsigned gen = old / nloc;
        if (old + 1u == (gen + 1u) * nloc) {
            __builtin_amdgcn_fence(__ATOMIC_RELEASE, "agent");
            asm volatile("s_waitcnt vmcnt(0)" ::: "memory");
            const unsigned og = xb_add(&bar[XB_TOP], 1u);
            const unsigned tg = og / nx;
            if (og + 1u == (tg + 1u) * nx) xb_add(&bar[XB_TOPGEN], 1u);
            else XB_SPIN(xb_ld(&bar[XB_TOPGEN]) == tg, bar);
            __builtin_amdgcn_fence(__ATOMIC_ACQUIRE, "agent");
            xb_add(&bar[XB_XGEN(b.x)], 1u);
            asm volatile("s_waitcnt vmcnt(0)" ::: "memory");
        } else {
            XB_SPIN(xb_ld(&bar[XB_XGEN(b.x)]) == gen, bar);
            __builtin_amdgcn_fence(__ATOMIC_ACQUIRE, "agent");
            asm volatile("s_waitcnt vmcnt(0)" ::: "memory");
        }
    }
    __syncthreads();
}

struct Args { const float* in[9]; float* out; unsigned char* ws; };
__device__ __forceinline__ void load_args(Args& A) {
    const __attribute__((address_space(4))) Args* ap_ = (const __attribute__((address_space(4))) Args*)__builtin_amdgcn_kernarg_segment_ptr(); asm volatile("" : "+s"(ap_));
#pragma unroll
    for (int i = 0; i < 9; ++i) A.in[i] = ap_->in[i];
    A.out = ap_->out; A.ws = ap_->ws;
}
#define ARGS_FRESH(A) Args A; load_args(A)

__device__ __forceinline__ void phase_weights(LAS unsigned char* lds) {
    int tid = threadIdx.x; asm volatile("" : "+v"(tid)); const int lane = tid & 63, wave = __builtin_amdgcn_readfirstlane(tid >> 6); (void)lane; (void)wave;
    ARGS_FRESH(A);
    LAS float* scr = (LAS float*)(lds + wave * 16384);
    const int gw = blockIdx.x * NWAVES + wave, NGW = gridDim.x * NWAVES;
    for (int i = gw * 64 + lane; i < 4 * SEQ; i += NGW * 64) ((float*)(A.ws + WS_ALIBI))[i] = -__builtin_amdgcn_exp2f(-2.f * (float)((i >> 12) + 1)) * LOG2E * (float)(i & (SEQ - 1));
    constexpr int I_IN = 16 * 144, I_B = 3 * 8 * 32, I_O = 16 * 32, I_LAYER = 2 * I_IN + I_B + I_O;
    for (int it = gw; it < NLAYER * I_LAYER; it += NGW) {
        const int l = it / I_LAYER; int r = it % I_LAYER;
        bf16* wl = (bf16*)(A.ws + WS_W + (size_t)l * W_LAYER);
        const float* w_in = A.in[2] + (size_t)l * DM * INW;
        if (r < I_IN) { const int kb = r / 144, n0 = (r % 144) * 32; transpose_item(w_in + src_col_qkv(n0), INW, 1024, (bf16*)((unsigned char*)wl + W_QKV) + (size_t)n0 * 1024, scr, kb, lane); continue; } r -= I_IN;
        if (r < I_IN) { const int kb = r / 144, n0 = (r % 144) * 32; transpose_item(w_in + src_col_zg(n0), INW, 1024, (bf16*)((unsigned char*)wl + W_ZG) + (size_t)n0 * 1024, scr, kb, lane); continue; } r -= I_IN;
        if (r < I_B) { const int nb = r / 256, rr = r % 256, kb = rr / 32, n0 = (rr % 32) * 32;
            transpose_item(A.in[6] + ((size_t)(l * 3 + nb) * 512) * 1024 + n0, 1024, 512, (bf16*)((unsigned char*)wl + W_B) + ((size_t)nb * 1024 + n0) * 512, scr, kb, lane); continue; } r -= I_B;
        { const int kb = r / 32, n0 = (r % 32) * 32; transpose_item(A.in[7] + (size_t)l * 1024 * 1024 + n0, 1024, 1024, (bf16*)((unsigned char*)wl + W_O) + (size_t)n0 * 1024, scr, kb, lane); }
    }
}

__device__ __forceinline__ void phase_norm(int l, bool first, LAS unsigned char* lds) {
    int tid = threadIdx.x; asm volatile("" : "+v"(tid)); const int lane = tid & 63, wave = __builtin_amdgcn_readfirstlane(tid >> 6); (void)lane; (void)wave;
    ARGS_FRESH(A); asm volatile("" : "+s"(l)); const float* xin = first ? A.in[0] : A.out;
    LAS float* wf = (LAS float*)lds;
    const float* w_in = A.in[2] + (size_t)l * DM * INW;
    for (int idx = tid; idx < 8192; idx += NWAVES * 64) { const int k = idx >> 3, h = idx & 7; wf[h * 1024 + k] = w_in[(size_t)k * INW + 3584 + h]; }
    __syncthreads();
    if (blockIdx.x == 0 && wave == 0) {
        const float* dl = A.in[4] + (size_t)l * 256;
        const float sa = wave_sum(dl[lane] * dl[64 + lane]), sb = wave_sum(dl[128 + lane] * dl[192 + lane]);
        const float lam_init = 0.8f - 0.6f * expf(-0.3f * (float)l);
        if (lane == 0) ((float*)(A.ws + WS_CTL))[CW_LAM + l] = expf(sa) - expf(sb) + lam_init;
    }
    const float* g = A.in[1] + (size_t)l * DM; const float* fb = A.in[3] + l * 8;
    bf16* XN = (bf16*)(A.ws + WS_XN); float* LOGF = (float*)(A.ws + WS_LOGF);
    f32x4 gv[4];
#pragma unroll
    for (int j = 0; j < 4; ++j) gv[j] = *(const f32x4*)(g + 4 * lane + 256 * j);
    f32x4 wr[8][4];
#pragma unroll
    for (int h = 0; h < 8; ++h)
#pragma unroll
        for (int j = 0; j < 4; ++j) wr[h][j] = *(const LAS f32x4*)(wf + h * 1024 + 4 * lane + 256 * j);
    const bool b0 = lane & 1, b1 = lane & 2, b2 = lane & 4;
    const int head = 4 * (lane & 1) + (lane & 2) + ((lane >> 2) & 1);
    const float fbv = fb[head];
    const int gw = blockIdx.x * NWAVES + wave, NGW = gridDim.x * NWAVES;
    auto load_row = [&](f32x4 (&d)[4], int m) { const f32x4* xr = (const f32x4*)(xin + (size_t)m * DM) + lane;
#pragma unroll
        for (int j = 0; j < 4; ++j) d[j] = first ? __builtin_nontemporal_load(xr + 64 * j) : xr[64 * j]; };
    auto do_row = [&](f32x4 (&v)[4], const int m) {
        float ss = 0.f;
#pragma unroll
        for (int j = 0; j < 4; ++j) ss += (v[j].x * v[j].x + v[j].y * v[j].y) + (v[j].z * v[j].z + v[j].w * v[j].w);
        const float rs = 1.f / sqrtf(wave_sum(ss) * (1.f / DM) + RMS_EPS);
        unsigned long long* o8 = (unsigned long long*)(XN + (size_t)m * DM) + lane;
        typedef float f32x2_n __attribute__((ext_vector_type(2)));
        f32x2_n f2[8];
#pragma unroll
        for (int h = 0; h < 8; ++h) f2[h] = (f32x2_n){0.f, 0.f};
#pragma unroll
        for (int j = 0; j < 4; ++j) { v[j] = v[j] * rs * gv[j];
            o8[64 * j] = (unsigned long long)pg8::cvt_pk_bf16(v[j].x, v[j].y) | ((unsigned long long)pg8::cvt_pk_bf16(v[j].z, v[j].w) << 32);
            const f32x2_n vlo = {v[j].x, v[j].y}, vhi = {v[j].z, v[j].w};
#pragma unroll
            for (int h = 0; h < 8; ++h) { const f32x4 w4 = wr[h][j]; f2[h] += vlo * (f32x2_n){w4.x, w4.y}; f2[h] += vhi * (f32x2_n){w4.z, w4.w}; } }
        float f[8];
#pragma unroll
        for (int h = 0; h < 8; ++h) f[h] = f2[h][0] + f2[h][1];
        float g4[4], g2[2];
#pragma unroll
        for (int i = 0; i < 4; ++i) { const float keep = b0 ? f[4 + i] : f[i], send = b0 ? f[i] : f[4 + i]; g4[i] = keep + __shfl_xor(send, 1); }
#pragma unroll
        for (int i = 0; i < 2; ++i) { const float keep = b1 ? g4[2 + i] : g4[i], send = b1 ? g4[i] : g4[2 + i]; g2[i] = keep + __shfl_xor(send, 2); }
        float fs; { const float keep = b2 ? g2[1] : g2[0], send = b2 ? g2[0] : g2[1]; fs = keep + __shfl_xor(send, 4); }
        fs += __shfl_xor(fs, 8); fs += __shfl_xor(fs, 16); fs += __shfl_xor(fs, 32);
        if (lane < 8) { const float xv = fs + fbv;
            const float ls2 = fminf(xv, 0.f) * LOG2E - __builtin_amdgcn_logf(1.f + __builtin_amdgcn_exp2f(-fabsf(xv) * LOG2E));
            LOGF[((size_t)(m / SEQ) * 8 + head) * SEQ + (m % SEQ)] = ls2; } };
    f32x4 va[4], vb[4];
    if (gw < MTOK) load_row(va, gw);
    if (gw + NGW < MTOK) load_row(vb, gw + NGW);
    for (int m = gw; m < MTOK; m += 2 * NGW) {
        { f32x4 v[4];
#pragma unroll
          for (int j = 0; j < 4; ++j) v[j] = va[j];
          if (m + 2 * NGW < MTOK) load_row(va, m + 2 * NGW);
          asm volatile("" ::: "memory");
          do_row(v, m); }
        if (m + NGW >= MTOK) break;
        { f32x4 v[4];
#pragma unroll
          for (int j = 0; j < 4; ++j) v[j] = vb[j];
          if (m + 3 * NGW < MTOK) load_row(vb, m + 3 * NGW);
          asm volatile("" ::: "memory");
          do_row(v, m + NGW); }
    }
    __syncthreads();
}
__device__ __forceinline__ void phase_cumsum(LAS unsigned char* lds) {
    int tid = threadIdx.x; asm volatile("" : "+v"(tid)); const int lane = tid & 63, wave = __builtin_amdgcn_readfirstlane(tid >> 6);
    if (blockIdx.x >= 64) return;
    ARGS_FRESH(A);
    const int bh = blockIdx.x;
    volatile LAS float* wt = (volatile LAS float*)(lds + LDSCTL_OFF + 64);
    const float* src = (const float*)(A.ws + WS_LOGF) + (size_t)bh * SEQ + 512 * wave + 8 * lane; float* dst = (float*)(A.ws + WS_CL2) + (size_t)bh * SEQ + 512 * wave + 8 * lane;
    f32x4 v0 = ((const f32x4*)src)[0], v1 = ((const f32x4*)src)[1];
    v0.y += v0.x; v0.z += v0.y; v0.w += v0.z; v1.x += v0.w; v1.y += v1.x; v1.z += v1.y; v1.w += v1.z;
    const float tot = v1.w; float inc = tot;
#pragma unroll
    for (int o = 1; o < 64; o <<= 1) { const float t = __shfl_up(inc, o); if (lane >= o) inc += t; }
    if (lane == 63) wt[wave] = inc;
    __syncthreads();
    float run = inc - tot;
#pragma unroll
    for (int w = 0; w < NWAVES - 1; ++w) run += (w < wave) ? wt[w] : 0.f;
    v0 = v0 + run; v1 = v1 + run;
    ((f32x4*)dst)[0] = v0; ((f32x4*)dst)[1] = v1;
}
__device__ __forceinline__ void phase_final() {
    int tid = threadIdx.x; asm volatile("" : "+v"(tid)); const int lane = tid & 63, wave = __builtin_amdgcn_readfirstlane(tid >> 6); (void)lane; (void)wave;
    ARGS_FRESH(A);
    const float* g = A.in[8]; float* X = A.out;
    f32x4 gv[4];
#pragma unroll
    for (int j = 0; j < 4; ++j) gv[j] = *(const f32x4*)(g + 4 * lane + 256 * j);
    const int gw = blockIdx.x * NWAVES + wave, NGW = gridDim.x * NWAVES;
    auto load_row = [&](f32x4 (&d)[4], int m) { const f32x4* xr = (const f32x4*)(X + (size_t)m * DM) + lane;
#pragma unroll
        for (int j = 0; j < 4; ++j) d[j] = xr[64 * j]; };
    auto do_row = [&](const f32x4 (&v)[4], const int m) {
        f32x4* xr = (f32x4*)(X + (size_t)m * DM) + lane; float ss = 0.f;
#pragma unroll
        for (int j = 0; j < 4; ++j) ss += (v[j].x * v[j].x + v[j].y * v[j].y) + (v[j].z * v[j].z + v[j].w * v[j].w);
        const float rs = 1.f / sqrtf(wave_sum(ss) * (1.f / DM) + RMS_EPS);
#pragma unroll
        for (int j = 0; j < 4; ++j) xr[64 * j] = v[j] * rs * gv[j]; };
    f32x4 va[4], vb[4];
    if (gw < MTOK) load_row(va, gw);
    if (gw + NGW < MTOK) load_row(vb, gw + NGW);
    for (int m = gw; m < MTOK; m += 2 * NGW) {
        { f32x4 v[4];
#pragma unroll
          for (int j = 0; j < 4; ++j) v[j] = va[j];
          if (m + 2 * NGW < MTOK) load_row(va, m + 2 * NGW);
          asm volatile("" ::: "memory");
          do_row(v, m); }
        if (m + NGW >= MTOK) break;
        { f32x4 v[4];
#pragma unroll
          for (int j = 0; j < 4; ++j) v[j] = vb[j];
          if (m + 3 * NGW < MTOK) load_row(vb, m + 3 * NGW);
          asm volatile("" ::: "memory");
          do_row(v, m + NGW); }
    }
}
__device__ __forceinline__ void phase_attention(int l, LAS unsigned char* lds) {
    int tid = threadIdx.x; asm volatile("" : "+v"(tid)); const int lane = tid & 63, wave = __builtin_amdgcn_readfirstlane(tid >> 6); (void)lane; (void)wave;
    ARGS_FRESH(A); asm volatile("" : "+s"(l));
    unsigned* qhead = (unsigned*)(A.ws + WS_CTL) + CW_QUEUE + 64 * l;
    volatile LAS unsigned* misc = (volatile LAS unsigned*)(lds + LDSCTL_OFF + 128);
    bf16* QKV = (bf16*)(A.ws + WS_QKV); const size_t BUF = (size_t)MTOK * 512;
    const float lam = ((const float*)(A.ws + WS_CTL))[CW_LAM + l];
    const float post = 1.f - (0.8f - 0.6f * expf(-0.3f * (float)l));
    unsigned nxt = blockIdx.x;
    for (;;) {
        if (tid == 0) misc[0] = nxt;
        __syncthreads();
        const int idx = (int)misc[0];
        __syncthreads();
        if (idx >= att::N_ATT_UNITS) break;
        if (tid == 0) nxt = atomicAdd(qhead, 1u) + gridDim.x;
        if (idx < att::N_DIFF_UNITS) {
            const int qb = 15 - idx / 32, bh = idx % 32, b = bh >> 2, h = bh & 3;
            att::diff_unit((LAS char*)lds, b, h, qb, QKV + 0 * BUF, QKV + 3 * BUF, QKV + 4 * BUF, lam, post, A.in[5] + (size_t)l * 512 + h * 128);
        } else if (idx < att::N_DIFF_UNITS + att::N_FOX_UNITS) {
            int tid2 = threadIdx.x; asm volatile("" : "+v"(tid2));
            const int j = idx - att::N_DIFF_UNITS, qb = 15 - j / 64, bh = j % 64, b = bh >> 3, h = bh & 7; const size_t t0 = (size_t)b * SEQ;
            bf16* Qr = QKV + 1 * BUF + (t0 + qb * 256) * 512 + h * 64;
            af::fast_pass<64, 0, 0>(Qr, QKV + 5 * BUF + t0 * 512 + h * 64, QKV + 6 * BUF + t0 * 512 + h * 64, (const float*)(A.ws + WS_CL2) + (size_t)bh * SEQ, qb, (LAS char*)lds, 0.f, tid2);
            af::fox_final((LAS char*)lds, Qr, tid2);
        } else {
            const int j = idx - att::N_DIFF_UNITS - att::N_FOX_UNITS, p = j >> 9, jj = j & 511, bhp = jj >> 4, sub = jj & 15, b = bhp >> 2, hp = bhp & 3;
            const int npair = 16 >> (2 * p), r = sub / npair, pj = sub % npair;
            att::dil_pair((LAS char*)lds, p, b, hp, r, pj, QKV + 2 * BUF, QKV + 7 * BUF, QKV + 8 * BUF, (bf16*)(A.ws + WS_DILO), (float*)(A.ws + WS_LSE));
        }
    }
}

#define GRID_SYNC() do { ARGS_FRESH(Ab); XcdBarrier bar_; bar_.bar = (unsigned*)(Ab.ws + WS_CTL) + CW_BAR; bar_.x = xb_xcc_id(); bar_.st = (volatile LAS unsigned*)(lds + LDSCTL_OFF) + 8; xcd_barrier(bar_); } while (0)
#define FRESH() ARGS_FRESH(A); unsigned char* ws = A.ws; int l = lyr; asm volatile("" : "+s"(l))
__device__ __forceinline__ void layer_phases(const int lyr, LAS unsigned char* lds, const int G, const int bx) {
        phase_cumsum(lds);
        { FRESH(); pg8::Gemm g{(const bf16*)(ws + WS_XN), (const bf16*)(ws + WS_W + (size_t)l * W_LAYER + W_QKV), MTOK, 4608, 1024}; pg8::StaticOrder S; S.init(MTOK, 4608, G, bx);
          pg8::EpiQKV E{(bf16*)(ws + WS_QKV)};

          pg8::gemm_phase<pg8::EpiQKV, pg8::StaticOrder, true, true>(lds, g, S, E);
          }
        GRID_SYNC();
        phase_attention(lyr, lds);
        GRID_SYNC();
        { FRESH(); pg8::Gemm g{(const bf16*)(ws + WS_XN), (const bf16*)(ws + WS_W + (size_t)l * W_LAYER + W_ZG), MTOK, 4608, 1024}; pg8::StaticOrder S; S.init(MTOK, 4608, G, bx);
          pg8::EpiZG E{(bf16*)(ws + WS_QKV), (bf16*)(ws + WS_GATES), (const bf16*)(ws + WS_DILO), (const float*)(ws + WS_LSE)};

          pg8::gemm_phase<pg8::EpiZG, pg8::StaticOrder, true, true>(lds, g, S, E);
          }
        GRID_SYNC();
        { FRESH(); pg8::BranchOrder S; S.init(MTOK, 1024, G, bx);
          pg8::Gemm g{(const bf16*)(ws + WS_QKV), (const bf16*)(ws + WS_W + (size_t)l * W_LAYER + W_B), MTOK, 1024, 512}; pg8::EpiBranchZ E{(const bf16*)(ws + WS_GATES), (bf16*)(ws + WS_XN)};
          pg8::gemm_phase<pg8::EpiBranchZ, pg8::BranchOrder, false, true, QKV_BUF, (size_t)1024 * 512 * 2>(lds, g, S, E);
          }
        GRID_SYNC();
        { FRESH(); pg8::Gemm g{(const bf16*)(ws + WS_XN), (const bf16*)(ws + WS_W + (size_t)l * W_LAYER + W_O), MTOK, 1024, 1024}; pg8::StaticOrder S; S.init(MTOK, 1024, G, bx);
          pg8::EpiOut E{l == 0 ? A.in[0] : A.out, A.out};

          pg8::gemm_phase<pg8::EpiOut, pg8::StaticOrder, false, true>(lds, g, S, E);
          }
        GRID_SYNC();
        if (lyr + 1 < NLAYER) { phase_norm(lyr + 1, false, lds); GRID_SYNC(); }
    }

__global__ void __launch_bounds__(NWAVES * 64, 2) fwd_megakernel(Args Akarg) {
    extern __shared__ __attribute__((aligned(16))) unsigned char lds_raw[];
    LAS unsigned char* lds = (LAS unsigned char*)lds_raw;
    const int G = gridDim.x, bx = blockIdx.x;
    if (threadIdx.x < 64) ((LAS unsigned*)(lds + LDSCTL_OFF))[threadIdx.x] = 0u;
    __syncthreads();
    { ARGS_FRESH(A); (void)xcd_barrier_post((unsigned*)(A.ws + WS_CTL) + CW_BAR, (volatile LAS unsigned*)(lds + LDSCTL_OFF) + 8); }
    phase_weights(lds);
    __syncthreads();
    phase_norm(0, true, lds);
    GRID_SYNC();
    layer_phases(0, lds, G, bx);
    layer_phases(1, lds, G, bx);
    phase_final();
}

extern "C" void kernel_launch(void* const* d_in, const int* in_sizes, int n_in, void* d_out, int out_size, void* d_ws, size_t ws_size, hipStream_t stream) {
    static int grid = 0;
    if (grid == 0) {
        if (n_in != 9 || in_sizes[0] != MTOK * DM || out_size != MTOK * DM || ws_size < WS_END) { fprintf(stderr, "kernel_launch: unexpected shapes (n_in %d, in0 %d, out %d, ws %zu); nothing launched\n", n_in, n_in > 0 ? in_sizes[0] : -1, out_size, ws_size); grid = -1; return; }
        int dev = 0, cus = 0, per_cu = 0;
        if (hipGetDevice(&dev) != hipSuccess || hipDeviceGetAttribute(&cus, hipDeviceAttributeMultiprocessorCount, dev) != hipSuccess) { grid = -1; return; }
        if (hipFuncSetAttribute((const void*)fwd_megakernel, hipFuncAttributeMaxDynamicSharedMemorySize, LDS_BYTES) != hipSuccess) { fprintf(stderr, "kernel_launch: hipFuncSetAttribute failed\n"); grid = -1; return; }
        if (hipOccupancyMaxActiveBlocksPerMultiprocessor(&per_cu, (const void*)fwd_megakernel, NWAVES * 64, LDS_BYTES) != hipSuccess || per_cu < 1) { fprintf(stderr, "kernel_launch: occupancy query says %d blocks per CU\n", per_cu); (void)hipGetLastError(); grid = -1; return; }
        grid = cus * per_cu;
    }
    if (grid < 0) return;
    if (hipMemsetAsync((char*)d_ws + WS_CTL, 0, CTL_ZERO_BYTES, stream) != hipSuccess) { fprintf(stderr, "kernel_launch: hipMemsetAsync failed\n"); return; }
    Args a{};
    for (int i = 0; i < 9; ++i) a.in[i] = (const float*)d_in[i];
    a.out = (float*)d_out; a.ws = (unsigned char*)d_ws;
    void* args[] = {&a};
    hipError_t e = hipLaunchCooperativeKernel((const void*)fwd_megakernel, dim3(grid), dim3(NWAVES * 64), args, LDS_BYTES, stream);
    if (e != hipSuccess) fprintf(stderr, "kernel_launch: cooperative launch failed: %s (grid %d)\n", hipGetErrorString(e), grid);
}
```
